# Optimizing an MI355X kernel written in HIP

```python
import math
import functools
import jax
import jax.numpy as jnp
from jax import lax
import numpy as np

D_MODEL = 1024
BATCH = 16
SEQ = 2048
DEPTH = 2

GRID_W = 64
CTX_LEN = 256
CHUNK = 64
EPS = 1e-6
N_MOD = 6

HY_WIDTH = D_MODEL // 4
HY_ORDER = 2
HY_SHORT = 3
HY_EMB = 33
HY_HIDDEN = 64
HY_FAST_DECAY = 0.3
HY_SLOW_DECAY = 1.5
HY_TARGET = 1e-2
GDN_HEADS = D_MODEL // 256
GDN_DK = 128
GDN_DV = 128
GDN_SHORT = 3
RET_HEADS = D_MODEL // 256
RET_DK = 64
RET_DV = 64
ROPE_BASE = 10000.0

MIX_WIDTH = HY_WIDTH + GDN_HEADS * GDN_DV + RET_HEADS * RET_DV
FFN_HIDDEN = ((8 * D_MODEL + 3 * 256 - 1) // (3 * 256)) * 256
IN_SIZES = (
    3 * HY_WIDTH,
    2 * GDN_HEADS * GDN_DK + GDN_HEADS * GDN_DV,
    GDN_HEADS * GDN_DV,
    2 * GDN_HEADS,
    2 * GDN_HEADS,
    RET_HEADS * RET_DK,
    RET_HEADS * RET_DK,
    RET_HEADS * RET_DV,
    RET_HEADS * RET_DV,
)
IN_WIDTH = sum(IN_SIZES)

kernel_name = 'hybrid_hyena_gdn_retention_dit'


def rmsnorm(x, g):
    xf = x.astype(jnp.float32)
    y = xf * lax.rsqrt(jnp.mean(xf * xf, axis=-1, keepdims=True) + EPS)
    return (y * g.astype(jnp.float32)).astype(x.dtype)


def modulate(h, shift, scale):
    return h * (1 + scale) + shift


def split_cols(p, sizes):
    parts, start = [], 0
    for s in sizes:
        parts.append(p[..., start:start + s])
        start += s
    return parts


def short_conv(x, w):
    k_w = w.shape[0]
    pad = k_w // 2
    L = x.shape[1]
    xp = jnp.pad(x, ((0, 0), (pad, pad), (0, 0)))
    return sum(xp[:, j:j + L] * w[j] for j in range(k_w))


def to_heads(t, n_heads, d_head):
    b, l, _ = t.shape
    return t.reshape(b, l, n_heads, d_head).transpose(0, 2, 1, 3).astype(jnp.float32)


def l2norm(x):
    return x * lax.rsqrt(jnp.sum(x * x, axis=-1, keepdims=True) + EPS)


def hyena_filters(L, lp):
    pos = jnp.arange(L, dtype=jnp.float32)
    t = jnp.linspace(0.0, 1.0, L, dtype=jnp.float32)
    bands = (HY_EMB - 1) // 2
    f = jnp.linspace(1e-4, bands - 1, bands, dtype=jnp.float32)
    ang = (2.0 * math.pi / L) * pos[:, None] * f[None, :]
    z = jnp.concatenate([t[:, None], jnp.cos(ang), -jnp.sin(ang)], axis=-1)
    h = jnp.sin(lp['hy_f_freq1'] * (z @ lp['hy_f_w1'] + lp['hy_f_b1']))
    h = jnp.sin(lp['hy_f_freq2'] * (h @ lp['hy_f_w2'] + lp['hy_f_b2']))
    h = (h @ lp['hy_f_w3']).astype(jnp.float32).reshape(L, HY_ORDER, 2, HY_WIDTH)
    max_decay = math.log(HY_TARGET) / HY_FAST_DECAY
    min_decay = math.log(HY_TARGET) / HY_SLOW_DECAY
    deltas = jnp.abs(jnp.linspace(min_decay, max_decay, HY_WIDTH, dtype=jnp.float32))
    window = jnp.exp(-t[:, None] * deltas[None, :])
    return h * window[:, None, None, :]


def two_sided_kernel(h_pos, h_neg):
    return jnp.concatenate([h_pos, jnp.zeros_like(h_pos[:1]), h_neg[:0:-1]], axis=0)


def long_conv(u, kern):
    L = u.shape[1]
    uf = jnp.fft.rfft(u, n=2 * L, axis=1)
    kf = jnp.fft.rfft(kern, axis=0)
    return jnp.fft.irfft(uf * kf[None], n=2 * L, axis=1)[:, :L]


def hyena_mixer(p, lp):
    L = p.shape[1]
    p = (short_conv(p, lp['hy_conv_w']) + lp['hy_conv_b']).astype(jnp.float32)
    v, x1, x2 = jnp.split(p, 3, axis=-1)
    h = hyena_filters(L, lp)
    bias_d = lp['hy_bias'].astype(jnp.float32)
    z = v
    for n, gate in enumerate((x1, x2)):
        kern = two_sided_kernel(h[:, n, 0], h[:, n, 1])
        z = gate * (long_conv(z, kern) + z * bias_d[n])
    return z


def gdn_prepare(qkv, a, b, lp):
    qkv = jax.nn.silu(short_conv(qkv, lp['gdn_conv_w']))
    q, k, v = split_cols(qkv, (GDN_HEADS * GDN_DK, GDN_HEADS * GDN_DK, GDN_HEADS * GDN_DV))
    q = l2norm(to_heads(q, GDN_HEADS, GDN_DK)) * (GDN_DK ** -0.5)
    k = l2norm(to_heads(k, GDN_HEADS, GDN_DK))
    v = to_heads(v, GDN_HEADS, GDN_DV)
    bsz, L, _ = a.shape
    a = a.astype(jnp.float32).reshape(bsz, L, 2, GDN_HEADS)
    b = b.astype(jnp.float32).reshape(bsz, L, 2, GDN_HEADS)
    a_log = lp['gdn_a_log'].astype(jnp.float32)
    dt_bias = lp['gdn_dt_bias'].astype(jnp.float32)
    g = -jnp.exp(a_log) * jax.nn.softplus(a + dt_bias)
    beta = jax.nn.sigmoid(b)
    return q, k, v, g.transpose(2, 0, 3, 1), beta.transpose(2, 0, 3, 1)


def gated_delta_chunk(q, k, v, g, beta, s0):
    bsz, nh, L, dk = q.shape
    dv = v.shape[-1]
    n = L // CHUNK
    if s0 is None:
        s0 = jnp.zeros((bsz, nh, dk, dv), jnp.float32)
    q, k, v = (t.reshape(bsz, nh, n, CHUNK, t.shape[-1]) for t in (q, k, v))
    g, beta = (t.reshape(bsz, nh, n, CHUNK) for t in (g, beta))
    gc = jnp.cumsum(g, axis=-1)
    idx = jnp.arange(CHUNK)
    incl = idx[:, None] >= idx[None, :]
    strict = idx[:, None] > idx[None, :]
    decay = jnp.exp(jnp.where(incl, gc[..., :, None] - gc[..., None, :], -jnp.inf))
    kb = k * beta[..., None]
    lmat = jnp.where(strict, jnp.einsum('bhncd,bhnsd->bhncs', kb, k) * decay, 0.0)
    eye = jnp.eye(CHUNK, dtype=jnp.float32)
    t_inv = lax.linalg.triangular_solve(eye + lmat, jnp.broadcast_to(eye, lmat.shape),
                                        left_side=True, lower=True, unit_diagonal=True)
    u = jnp.einsum('bhncs,bhnsv->bhncv', t_inv, v * beta[..., None])
    w = jnp.einsum('bhncs,bhnsd->bhncd', t_inv, kb * jnp.exp(gc)[..., None])
    attn = jnp.einsum('bhncd,bhnsd->bhncs', q, k) * decay
    qg = q * jnp.exp(gc)[..., None]
    kg = k * jnp.exp(gc[..., -1:] - gc)[..., None]
    glast = jnp.exp(gc[..., -1])

    def step(s, xs):
        u_n, w_n, attn_n, qg_n, kg_n, gl_n = xs
        v_new = u_n - jnp.einsum('bhck,bhkv->bhcv', w_n, s)
        o = jnp.einsum('bhck,bhkv->bhcv', qg_n, s) + jnp.einsum('bhcs,bhsv->bhcv', attn_n, v_new)
        s = s * gl_n[..., None, None] + jnp.einsum('bhck,bhcv->bhkv', kg_n, v_new)
        return s, o

    xs = tuple(jnp.moveaxis(t, 2, 0) for t in (u, w, attn, qg, kg, glast))
    s, o = lax.scan(step, s0, xs)
    return jnp.moveaxis(o, 0, 2).reshape(bsz, nh, L, dv), s


def axial_rope_angles(rows_n):
    row = jnp.repeat(jnp.arange(rows_n, dtype=jnp.float32), GRID_W)
    col = jnp.tile(jnp.arange(GRID_W, dtype=jnp.float32), rows_n)
    nf = RET_DK // 4
    inv = ROPE_BASE ** (-jnp.arange(nf, dtype=jnp.float32) / nf)
    ang = jnp.concatenate([row[:, None] * inv, col[:, None] * inv], axis=-1)
    return jnp.cos(ang), jnp.sin(ang)


def apply_rope(x, cos, sin):
    x1, x2 = jnp.split(x, 2, axis=-1)
    return jnp.concatenate([x1 * cos - x2 * sin, x1 * sin + x2 * cos], axis=-1)


def ret_prepare(q, k, v, rope):
    q = to_heads(q, RET_HEADS, RET_DK)
    k = to_heads(k, RET_HEADS, RET_DK) * (RET_DK ** -0.5)
    v = to_heads(v, RET_HEADS, RET_DV)
    if rope is not None:
        q, k = apply_rope(q, *rope), apply_rope(k, *rope)
    return q, k, v


def retention_chunk(q, k, v, s0, log_gamma):
    bsz, nh, L, dk = q.shape
    dv = v.shape[-1]
    n = L // CHUNK
    if s0 is None:
        s0 = jnp.zeros((bsz, nh, dk, dv), jnp.float32)
    q, k, v = (t.reshape(bsz, nh, n, CHUNK, t.shape[-1]) for t in (q, k, v))
    idx = jnp.arange(CHUNK, dtype=jnp.float32)
    rel = idx[:, None] - idx[None, :]
    dmat = jnp.exp(jnp.where(rel >= 0, rel * log_gamma[:, None, None], -jnp.inf))
    scores = jnp.einsum('bhncd,bhnsd->bhncs', q, k) * dmat[None, :, None]
    inner = jnp.einsum('bhncs,bhnsv->bhncv', scores, v)
    qd = q * jnp.exp((idx + 1.0)[None, :] * log_gamma[:, None])[None, :, None, :, None]
    kd = k * jnp.exp((CHUNK - 1.0 - idx)[None, :] * log_gamma[:, None])[None, :, None, :, None]
    g_chunk = jnp.exp(CHUNK * log_gamma)[None, :, None, None]

    def step(s, xs):
        qd_n, kd_n, v_n = xs
        o = jnp.einsum('bhck,bhkv->bhcv', qd_n, s)
        s = s * g_chunk + jnp.einsum('bhck,bhcv->bhkv', kd_n, v_n)
        return s, o

    xs = tuple(jnp.moveaxis(t, 2, 0) for t in (qd, kd, v))
    s, o_cross = lax.scan(step, s0, xs)
    o = inner + jnp.moveaxis(o_cross, 0, 2)
    return o.reshape(bsz, nh, L, dv), s


def prefix_scan(scan_fn, ctx_seq, lat_seq, reverse):
    if reverse:
        ctx_seq = tuple(jnp.flip(t, 2) for t in ctx_seq)
        lat_seq = tuple(jnp.flip(t, 2) for t in lat_seq)
    o_ctx, s_ctx = scan_fn(*ctx_seq, None)
    o_lat, _ = scan_fn(*lat_seq, s_ctx)
    if reverse:
        o_ctx, o_lat = jnp.flip(o_ctx, 2), jnp.flip(o_lat, 2)
    return o_ctx, o_lat


def gdn_output(o, z, norm_g):
    bsz, nh, L, dv = o.shape
    o = o.transpose(0, 2, 1, 3)
    z = z.astype(jnp.float32).reshape(bsz, L, nh, dv)
    y = o * lax.rsqrt(jnp.mean(o * o, axis=-1, keepdims=True) + EPS) * norm_g.astype(jnp.float32)
    return (y * jax.nn.silu(z)).reshape(bsz, L, nh * dv)


def ret_output(o, gate):
    bsz, nh, L, dv = o.shape
    o = o.transpose(0, 2, 1, 3)
    mu = jnp.mean(o, axis=-1, keepdims=True)
    var = jnp.mean(jnp.square(o - mu), axis=-1, keepdims=True)
    y = ((o - mu) * lax.rsqrt(var + EPS)).reshape(bsz, L, nh * dv)
    return y * jax.nn.silu(gate.astype(jnp.float32))


def token_mixers(h_lat, h_ctx, rope, lp, need_ctx):
    lat = split_cols(h_lat @ lp['w_in'], IN_SIZES)
    ctx = split_cols(h_ctx @ lp['w_in'], IN_SIZES)
    hy_lat = hyena_mixer(lat[0], lp)
    q_l, k_l, v_l, g_l, b_l = gdn_prepare(lat[1], lat[3], lat[4], lp)
    q_c, k_c, v_c, g_c, b_c = gdn_prepare(ctx[1], ctx[3], ctx[4], lp)
    gc_f, gl_f = prefix_scan(gated_delta_chunk, (q_c, k_c, v_c, g_c[0], b_c[0]),
                             (q_l, k_l, v_l, g_l[0], b_l[0]), reverse=False)
    gc_b, gl_b = prefix_scan(gated_delta_chunk, (q_c, k_c, v_c, g_c[1], b_c[1]),
                             (q_l, k_l, v_l, g_l[1], b_l[1]), reverse=True)
    log_gamma = jax.nn.log_sigmoid(lp['ret_decay_logit'].astype(jnp.float32))
    rq_l, rk_l, rv_l = ret_prepare(lat[5], lat[6], lat[7], rope)
    rq_c, rk_c, rv_c = ret_prepare(ctx[5], ctx[6], ctx[7], None)
    rc_f, rl_f = prefix_scan(functools.partial(retention_chunk, log_gamma=log_gamma[0]),
                             (rq_c, rk_c, rv_c), (rq_l, rk_l, rv_l), reverse=False)
    rc_b, rl_b = prefix_scan(functools.partial(retention_chunk, log_gamma=log_gamma[1]),
                             (rq_c, rk_c, rv_c), (rq_l, rk_l, rv_l), reverse=True)
    dt = h_lat.dtype
    y_lat = jnp.concatenate([hy_lat,
                             gdn_output(gl_f + gl_b, lat[2], lp['gdn_norm_g']),
                             ret_output(rl_f + rl_b, lat[8])], axis=-1).astype(dt) @ lp['w_out']
    y_ctx = None
    if need_ctx:
        y_ctx = jnp.concatenate([hyena_mixer(ctx[0], lp),
                                 gdn_output(gc_f + gc_b, ctx[2], lp['gdn_norm_g']),
                                 ret_output(rc_f + rc_b, ctx[8])], axis=-1).astype(dt) @ lp['w_out']
    return y_lat, y_ctx


def swiglu(h, lp):
    gate, up = jnp.split(h @ lp['ffn_w_in'], 2, axis=-1)
    return (jax.nn.silu(gate) * up) @ lp['ffn_w_out']


def trunk_layer(x, ctx, c, c_ctx, rope, lp, need_ctx):
    d = x.shape[-1]
    mod_lat = (jax.nn.silu(c) @ lp['mod_w'] + lp['mod_b']).reshape(c.shape[0], N_MOD, 1, d)
    mod_ctx = (jax.nn.silu(c_ctx) @ lp['mod_w'] + lp['mod_b']).reshape(N_MOD, d)
    h_lat = modulate(rmsnorm(x, lp['norm1_g']), mod_lat[:, 0], mod_lat[:, 1])
    h_ctx = modulate(rmsnorm(ctx, lp['norm1_g']), mod_ctx[0], mod_ctx[1])
    y_lat, y_ctx = token_mixers(h_lat, h_ctx, rope, lp, need_ctx)
    x = x + mod_lat[:, 2] * y_lat
    x = x + mod_lat[:, 5] * swiglu(modulate(rmsnorm(x, lp['norm2_g']), mod_lat[:, 3], mod_lat[:, 4]), lp)
    if need_ctx:
        ctx = ctx + mod_ctx[2] * y_ctx
        ctx = ctx + mod_ctx[5] * swiglu(modulate(rmsnorm(ctx, lp['norm2_g']), mod_ctx[3], mod_ctx[4]), lp)
    return x, ctx


def setup_inputs(seed: int = 0) -> dict:
    key = jax.random.key(seed)
    it = iter(jax.random.split(key, 32))
    f32 = jnp.float32

    def nrm(shape, scale):
        return scale * jax.random.normal(next(it), shape, f32)

    D = D_MODEL
    qkv_w = 2 * GDN_HEADS * GDN_DK + GDN_HEADS * GDN_DV
    gamma0 = 1.0 - 2.0 ** (-5.0 - jnp.arange(RET_HEADS, dtype=f32))
    dt0 = jnp.exp(jax.random.uniform(next(it), (DEPTH, 2, GDN_HEADS), f32, math.log(1e-3), math.log(1e-1)))
    return {
        'x': nrm((BATCH, SEQ, D), 1.0),
        'c': nrm((BATCH, D), 1.0),
        'ctx': nrm((BATCH, CTX_LEN, D), 1.0),
        'c_ctx': nrm((D,), 1.0),
        'mod_w': nrm((DEPTH, D, N_MOD * D), 0.5 * D ** -0.5),
        'mod_b': nrm((DEPTH, N_MOD * D), 0.02),
        'norm1_g': 1.0 + nrm((DEPTH, D), 0.02),
        'w_in': nrm((DEPTH, D, IN_WIDTH), D ** -0.5),
        'hy_conv_w': nrm((DEPTH, HY_SHORT, 3 * HY_WIDTH), HY_SHORT ** -0.5),
        'hy_conv_b': nrm((DEPTH, 3 * HY_WIDTH), 0.02),
        'hy_f_w1': nrm((DEPTH, HY_EMB, HY_HIDDEN), HY_EMB ** -0.5),
        'hy_f_b1': nrm((DEPTH, HY_HIDDEN), 0.02),
        'hy_f_freq1': 1.0 + nrm((DEPTH, HY_HIDDEN), 0.02),
        'hy_f_w2': nrm((DEPTH, HY_HIDDEN, HY_HIDDEN), HY_HIDDEN ** -0.5),
        'hy_f_b2': nrm((DEPTH, HY_HIDDEN), 0.02),
        'hy_f_freq2': 1.0 + nrm((DEPTH, HY_HIDDEN), 0.02),
        'hy_f_w3': nrm((DEPTH, HY_HIDDEN, HY_ORDER * 2 * HY_WIDTH), 0.05 * HY_HIDDEN ** -0.5),
        'hy_bias': nrm((DEPTH, HY_ORDER, HY_WIDTH), 0.5),
        'gdn_conv_w': nrm((DEPTH, GDN_SHORT, qkv_w), GDN_SHORT ** -0.5),
        'gdn_a_log': jnp.log(jax.random.uniform(next(it), (DEPTH, 2, GDN_HEADS), f32, 1.0, 16.0)),
        'gdn_dt_bias': dt0 + jnp.log(-jnp.expm1(-dt0)),
        'gdn_norm_g': 1.0 + nrm((DEPTH, GDN_DV), 0.02),
        'ret_decay_logit': jnp.log(gamma0 / (1.0 - gamma0)) + nrm((DEPTH, 2, RET_HEADS), 0.1),
        'w_out': nrm((DEPTH, MIX_WIDTH, D), MIX_WIDTH ** -0.5),
        'norm2_g': 1.0 + nrm((DEPTH, D), 0.02),
        'ffn_w_in': nrm((DEPTH, D, 2 * FFN_HIDDEN), D ** -0.5),
        'ffn_w_out': nrm((DEPTH, FFN_HIDDEN, D), FFN_HIDDEN ** -0.5),
        'final_norm_g': 1.0 + nrm((D,), 0.02),
    }


def reference(x, c, ctx, c_ctx, mod_w, mod_b, norm1_g, w_in, hy_conv_w, hy_conv_b, hy_f_w1, hy_f_b1,
              hy_f_freq1, hy_f_w2, hy_f_b2, hy_f_freq2, hy_f_w3, hy_bias, gdn_conv_w, gdn_a_log,
              gdn_dt_bias, gdn_norm_g, ret_decay_logit, w_out, norm2_g, ffn_w_in, ffn_w_out, final_norm_g):
    rows_n = x.shape[1] // GRID_W
    rope = axial_rope_angles(rows_n)
    for i in range(DEPTH):
        lp = {
            'mod_w': mod_w[i], 'mod_b': mod_b[i], 'norm1_g': norm1_g[i], 'w_in': w_in[i],
            'hy_conv_w': hy_conv_w[i], 'hy_conv_b': hy_conv_b[i],
            'hy_f_w1': hy_f_w1[i], 'hy_f_b1': hy_f_b1[i], 'hy_f_freq1': hy_f_freq1[i],
            'hy_f_w2': hy_f_w2[i], 'hy_f_b2': hy_f_b2[i], 'hy_f_freq2': hy_f_freq2[i],
            'hy_f_w3': hy_f_w3[i], 'hy_bias': hy_bias[i],
            'gdn_conv_w': gdn_conv_w[i], 'gdn_a_log': gdn_a_log[i], 'gdn_dt_bias': gdn_dt_bias[i],
            'gdn_norm_g': gdn_norm_g[i], 'ret_decay_logit': ret_decay_logit[i],
            'w_out': w_out[i], 'norm2_g': norm2_g[i], 'ffn_w_in': ffn_w_in[i], 'ffn_w_out': ffn_w_out[i],
        }
        x, ctx = trunk_layer(x, ctx, c, c_ctx, rope, lp, need_ctx=(i < DEPTH - 1))
    return rmsnorm(x, final_norm_g)
```

```cpp
#include <hip/hip_runtime.h>
#include <hip/hip_cooperative_groups.h>
#include <cstdio>
#include <cstdint>
namespace cg = cooperative_groups;

#ifndef MK_MULTI
#define MK_MULTI 0
#endif

#ifndef PHM
#define PHM 0xFFFF
#endif
#ifndef DUP
#define DUP 0
#endif
#define LAS __attribute__((address_space(3)))
typedef unsigned short bf16_t;
typedef short bf16x8 __attribute__((ext_vector_type(8)));
typedef float f32x4 __attribute__((ext_vector_type(4)));
typedef unsigned u32x4 __attribute__((ext_vector_type(4)));
typedef unsigned u32x2 __attribute__((ext_vector_type(2)));

constexpr int DM = 1024, NB = 16, SEQ = 2048, CTXL = 256, NLAT = NB * SEQ, NCTX = NB * CTXL, NTOK = NLAT + NCTX;
constexpr int INW = 3856, FFH = 2816;
constexpr int LDS_BYTES = 156 * 1024;
constexpr int PARAM_OFF = 155 * 1024;

struct Params {
    const float *x, *c, *ctx, *c_ctx, *mod_w, *mod_b, *norm1_g, *w_in, *hy_conv_w, *hy_conv_b, *hy_f_w1, *hy_f_b1, *hy_f_freq1, *hy_f_w2, *hy_f_b2, *hy_f_freq2,
        *hy_f_w3, *hy_bias, *gdn_conv_w, *gdn_a_log, *gdn_dt_bias, *gdn_norm_g, *ret_decay_logit, *w_out, *norm2_g, *ffn_w_in, *ffn_w_out, *final_norm_g;
    float* out;
    float* modbuf;
    bf16_t* Fl;
    bf16_t* Fc;
    bf16_t *Wt_in, *Wt_out, *Wt_f1, *Wt_f2;
    float* ctx_x;
    bf16_t* hbuf;
    float* ab;
    bf16_t* hyproj;
    bf16_t* proj;
    bf16_t* hyT;
    bf16_t* hyTc;
    bf16_t* Tbuf;
    bf16_t* hyO;
    bf16_t* hyOc;
    bf16_t* halo;
    float* ropeT;
    unsigned* ctl;
    float* gcbuf;
    long long ph_lo, ph_hi;
};

template <class T> __device__ __forceinline__ T* uni(T* ptr) { const unsigned long long v = (unsigned long long)ptr; const unsigned lo = __builtin_amdgcn_readfirstlane((unsigned)v), hi = __builtin_amdgcn_readfirstlane((unsigned)(v >> 32));
    return (T*)((__attribute__((address_space(1))) T*)(((unsigned long long)hi << 32) | lo)); }
#define LP(f) p.f = uni(lp->f)
__device__ __forceinline__ int otid() { int t = threadIdx.x; asm volatile("" : "+v"(t)); return t; }
#define NOINL __forceinline__
typedef __bf16 bf16v2_t __attribute__((ext_vector_type(2)));
typedef float f32v2_t __attribute__((ext_vector_type(2)));
__device__ __forceinline__ unsigned pk2(float lo, float hi) { const f32v2_t f = {lo, hi}; const bf16v2_t b = __builtin_convertvector(f, bf16v2_t); return __builtin_bit_cast(unsigned, b); }
__device__ __forceinline__ bf16_t f2bf(float f) { return (bf16_t)(pk2(f, f) & 0xFFFFu); }
__device__ __forceinline__ float bf2f(unsigned b) { return __uint_as_float(b << 16); }
__device__ __forceinline__ float bflo(unsigned u) { return __uint_as_float(u << 16); }
__device__ __forceinline__ float bfhi(unsigned u) { return __uint_as_float(u & 0xFFFF0000u); }
__device__ __forceinline__ float wave_sum(float v) {
#pragma unroll
    for (int o = 1; o < 64; o <<= 1) v += __shfl_xor(v, o);
    return v;
}
__device__ __forceinline__ float siluf(float v) { return v * __builtin_amdgcn_rcpf(1.f + __expf(-v)); }
__device__ __forceinline__ float softplusf(float v) { return fmaxf(v, 0.f) + log1pf(__expf(-fabsf(v))); }
#define WAVE_SYNC() do { asm volatile("s_waitcnt lgkmcnt(0)" ::: "memory"); __builtin_amdgcn_wave_barrier(); asm volatile("" ::: "memory"); } while (0)
#define MFMA16(a, b, c) __builtin_amdgcn_mfma_f32_16x16x32_bf16((a), (b), (c), 0, 0, 0)
__device__ __forceinline__ void unpack8(const u32x4 v, float* f) {
    f[0] = bflo(v.x); f[1] = bfhi(v.x); f[2] = bflo(v.y); f[3] = bfhi(v.y); f[4] = bflo(v.z); f[5] = bfhi(v.z); f[6] = bflo(v.w); f[7] = bfhi(v.w);
}

namespace pg8 {
constexpr int BM = 256, BK = 64, HALF = 128, HTB = HALF * BK * 2, STAGE_BYTES = 8 * HTB, NXCD = 8, WGM = 8;
__host__ __device__ __forceinline__ int lds_byte(int r, int c) { const int st = (r >> 4) * 2 + (c >> 5), rr = r & 15, cc = c & 31, ob = rr * 64 + cc * 2; return st * 1024 + (ob ^ (((ob >> 9) & 1) << 5)); }
__host__ __device__ __forceinline__ void stage_rc(int b, int& R, int& C) { const int st = b / 1024, sb = b % 1024, swz = sb ^ (((sb >> 9) & 1) << 5); R = (st >> 1) * 16 + swz / 64; C = (st & 1) * 32 + (swz % 64) / 2; }
__host__ __device__ __forceinline__ int perm32(int rho) { const int n = rho >> 4, i = rho & 15; return 8 * (i >> 2) + 4 * n + (i & 3); }
struct Gemm { const bf16_t* A; const bf16_t* Bt; int M, N, K; };
struct StaticOrder {
    int nM, nN, nwg, G, c, nkt, tail;
    __device__ __forceinline__ void init(int M, int N, int K, int G_, int c_, int tail_ = 0) { nM = M / BM; nN = N / BM; nwg = nM * nN; G = G_; c = c_; nkt = K / BK; tail = tail_; }
    __device__ __forceinline__ bool next(int i, int& pm, int& pn, int& k0, int& nk, int& split) const {
        const int L = i * G + c;
        if (L >= nwg) {
            if (!tail || L >= nwg + 256) return false;
            const int j = L - nwg, t = j >> 2, sp = j & 3;
            pm = 128 + (t >> 2); pn = t & 3; split = 1 + sp;
            const int q = (nkt / 4) & ~1, r = (nkt - 4 * q) / 2;
            k0 = sp * q + 2 * (sp < r ? sp : r); nk = q + (sp < r ? 2 : 0);
            return true;
        }
        k0 = 0; nk = nkt; split = 0;
        int wgid = L; { const int q = nwg / NXCD, r = nwg % NXCD, xcd = wgid % NXCD, off = wgid / NXCD; wgid = (xcd < r ? xcd * (q + 1) : r * (q + 1) + (xcd - r) * q) + off; }
        const int nig = WGM * nN, gid = wgid / nig, fm = gid * WGM, gsz = (nM - fm) < WGM ? (nM - fm) : WGM;
        pm = fm + ((wgid % nig) % gsz); pn = (wgid % nig) / gsz; return true;
    }
};
__device__ __forceinline__ unsigned cvt_pk_bf16(float lo, float hi) { return pk2(lo, hi); }

template <class Epi>
__device__ __forceinline__ void gemm_phase(LAS unsigned char* lds, const Gemm g, const StaticOrder& S, const Epi& E) {
    const int tid = otid(), wid = __builtin_amdgcn_readfirstlane(tid >> 6), lane = tid & 63, wr = wid >> 2, wc = wid & 3, fr = lane & 15, fq = lane >> 4;
    const int K = g.K;
    unsigned voffA[2], voffB[2];
#pragma unroll
    for (int i = 0; i < 2; ++i) { int R, C; stage_rc(tid * 16 + i * 8192, R, C); const int Rb = Epi::PERM ? ((R & ~31) + perm32(R & 31)) : R;
        voffA[i] = (unsigned)(R * K + C) * 2u; voffB[i] = (unsigned)(Rb * K + C) * 2u; }
    const size_t kstep = (size_t)(BK * 2);
    const size_t hstep = (size_t)HALF * K * 2;
    const size_t tstep = 2 * hstep;
    const unsigned ldsw = (unsigned)wid * 1024u;
    const int aoff = lds_byte(wr * 64 + fr, fq * 8), boff = lds_byte(wc * 32 + fr, fq * 8);
#define PG8_SA(b, h) (((b) * 2 + (h)) * HTB)
#define PG8_SB(b, h) ((4 + (b) * 2 + (h)) * HTB)
#define PG8_STAGE(bufoff, gbase, voff) do { _Pragma("unroll") for (int _i = 0; _i < 2; ++_i) \
        __builtin_amdgcn_global_load_lds((const unsigned*)((const char*)(gbase) + (voff)[_i]), (LAS unsigned*)(lds + (bufoff) + ldsw + _i * 8192), 16, 0, 0); } while (0)
#define PG8_LDA(dst, b, h) do { _Pragma("unroll") for (int m = 0; m < 4; ++m) _Pragma("unroll") for (int k = 0; k < 2; ++k) dst[m][k] = *(const LAS bf16x8*)(lds + PG8_SA(b, h) + aoff + m * 2048 + k * 1024); } while (0)
#define PG8_LDB(dst, b, h) do { _Pragma("unroll") for (int n = 0; n < 2; ++n) _Pragma("unroll") for (int k = 0; k < 2; ++k) dst[n][k] = *(const LAS bf16x8*)(lds + PG8_SB(b, h) + boff + n * 2048 + k * 1024); } while (0)
#define PG8_MMA(ai, bj, At, Bt) do { __builtin_amdgcn_s_setprio(1); _Pragma("unroll") for (int m = 0; m < 4; ++m) _Pragma("unroll") for (int n = 0; n < 2; ++n) _Pragma("unroll") for (int k = 0; k < 2; ++k) \
        acc[ai][bj][m][n] = __builtin_amdgcn_mfma_f32_16x16x32_bf16(Bt[n][k], At[m][k], acc[ai][bj][m][n], 0, 0, 0); __builtin_amdgcn_s_setprio(0); } while (0)
#define PG8_WAIT_V(n) asm volatile("s_waitcnt vmcnt(" #n ")" ::: "memory")
#define PG8_WAIT_L(n) asm volatile("s_waitcnt lgkmcnt(" #n ")" ::: "memory")
#define PG8_BAR __builtin_amdgcn_s_barrier()
#define PG8_SCHED __builtin_amdgcn_sched_barrier(0)
    int cpm, cpn, ck0, cnk, csp, npm = 0, npn = 0, nk0 = 0, nnk = 0, nsp = 0; int ui = 0;
    if (!S.next(0, cpm, cpn, ck0, cnk, csp)) return;
    f32x4 acc[2][2][4][2];
#pragma unroll
    for (int a = 0; a < 2; ++a)
#pragma unroll
        for (int b = 0; b < 2; ++b)
#pragma unroll
            for (int m = 0; m < 4; ++m)
#pragma unroll
                for (int n = 0; n < 2; ++n) acc[a][b][m][n] = (f32x4){0.f, 0.f, 0.f, 0.f};
    bf16x8 At[4][2], B0[2][2], B1[2][2];
    const char* cA = (const char*)g.A + (size_t)cpm * tstep + (size_t)ck0 * kstep; const char* cB = (const char*)g.Bt + (size_t)cpn * tstep + (size_t)ck0 * kstep;
    PG8_STAGE(PG8_SB(0, 0), cB, voffB); PG8_STAGE(PG8_SA(0, 0), cA, voffA); PG8_STAGE(PG8_SB(0, 1), cB + hstep, voffB); PG8_STAGE(PG8_SA(0, 1), cA + hstep, voffA);
    if (wr == 1) PG8_BAR;
    PG8_WAIT_V(4); PG8_BAR;
    PG8_STAGE(PG8_SB(1, 0), cB + kstep, voffB); PG8_STAGE(PG8_SA(1, 0), cA + kstep, voffA); PG8_STAGE(PG8_SB(1, 1), cB + hstep + kstep, voffB);
    PG8_WAIT_V(6); PG8_BAR;
    for (;;) {
        const bool has_next = S.next(ui + 1, npm, npn, nk0, nnk, nsp);
        const char* nA = has_next ? (const char*)g.A + (size_t)npm * tstep + (size_t)nk0 * kstep : cA; const char* nB = has_next ? (const char*)g.Bt + (size_t)npn * tstep + (size_t)nk0 * kstep : cB;
        const int nt = cnk;
        for (int t = 0; t < nt; t += 2) {
            const bool last = (t == nt - 2);
            const char* a1 = cA + (size_t)(t + 1) * kstep;
            const char* a2 = last ? nA : cA + (size_t)(t + 2) * kstep; const char* b2 = last ? nB : cB + (size_t)(t + 2) * kstep;
            const char* a3 = a2 + kstep; const char* b3 = b2 + kstep;
            PG8_LDB(B0, 0, 0); PG8_SCHED; PG8_LDA(At, 0, 0); PG8_STAGE(PG8_SA(1, 1), a1 + hstep, voffA);
            PG8_WAIT_L(8); PG8_BAR; PG8_WAIT_L(0); PG8_MMA(0, 0, At, B0); PG8_BAR; PG8_SCHED;
            PG8_LDB(B1, 0, 1); PG8_STAGE(PG8_SB(0, 0), b2, voffB);
            PG8_BAR; PG8_WAIT_L(0); PG8_MMA(0, 1, At, B1); PG8_BAR;
            PG8_LDA(At, 0, 1); PG8_STAGE(PG8_SA(0, 0), a2, voffA);
            PG8_BAR; PG8_WAIT_L(0); PG8_MMA(1, 0, At, B0); PG8_BAR; PG8_SCHED;
            PG8_STAGE(PG8_SB(0, 1), b2 + hstep, voffB);
            PG8_WAIT_V(6); PG8_BAR; PG8_MMA(1, 1, At, B1); PG8_BAR;
            PG8_LDB(B0, 1, 0); PG8_SCHED; PG8_LDA(At, 1, 0); PG8_STAGE(PG8_SA(0, 1), a2 + hstep, voffA);
            PG8_WAIT_L(8); PG8_BAR; PG8_WAIT_L(0); PG8_MMA(0, 0, At, B0); PG8_BAR; PG8_SCHED;
            PG8_LDB(B1, 1, 1); PG8_STAGE(PG8_SB(1, 0), b3, voffB);
            PG8_BAR; PG8_WAIT_L(0); PG8_MMA(0, 1, At, B1); PG8_BAR;
            PG8_LDA(At, 1, 1); PG8_STAGE(PG8_SA(1, 0), a3, voffA);
            PG8_BAR; PG8_WAIT_L(0); PG8_MMA(1, 0, At, B0); PG8_BAR; PG8_SCHED;
            PG8_STAGE(PG8_SB(1, 1), b3 + hstep, voffB);
            PG8_WAIT_V(6); PG8_BAR; PG8_MMA(1, 1, At, B1); PG8_BAR;
        }
        E(acc, cpm, cpn, csp, wr, wc, fr, fq);
        if (!has_next) break;
#pragma unroll
        for (int a = 0; a < 2; ++a)
#pragma unroll
            for (int b = 0; b < 2; ++b)
#pragma unroll
                for (int m = 0; m < 4; ++m)
#pragma unroll
                    for (int n = 0; n < 2; ++n) acc[a][b][m][n] = (f32x4){0.f, 0.f, 0.f, 0.f};
        cpm = npm; cpn = npn; ck0 = nk0; cnk = nnk; csp = nsp; cA = nA; cB = nB; ++ui;
    }
    PG8_WAIT_V(0);
    if (wr == 0) PG8_BAR;
    PG8_BAR;
}

struct EpiProj {
    static constexpr bool PERM = true;
    bf16_t* hyproj; bf16_t* proj; float* ab; bf16_t* halo;
    __device__ __forceinline__ void operator()(const f32x4 (&acc)[2][2][4][2], const int upm, const int upn, const int usplit, int wr, int wc, int fr, int fq) const {
        const int row0 = upm * BM + wr * 64 + fr;
#pragma unroll
        for (int ai = 0; ai < 2; ++ai)
#pragma unroll
            for (int m = 0; m < 4; ++m) {
                const size_t row = (size_t)(row0 + ai * HALF + m * 16);
#pragma unroll
                for (int bj = 0; bj < 2; ++bj) {
                    const f32x4 v0 = acc[ai][bj][m][0], v1 = acc[ai][bj][m][1];
                    const int col = upn * BM + bj * HALF + wc * 32 + 8 * fq;
                    if (upn == 15) {
                        if (bj == 0 && wc == 0 && fq < 2) { float* d = ab + row * 16 + 8 * fq; *(f32x4*)d = v0; *(f32x4*)(d + 4) = v1; }
                    } else {
                        u32x4 o; o.x = cvt_pk_bf16(v0[0], v0[1]); o.y = cvt_pk_bf16(v0[2], v0[3]); o.z = cvt_pk_bf16(v1[0], v1[1]); o.w = cvt_pk_bf16(v1[2], v1[3]);
                        bf16_t* d = (upn < 3) ? (hyproj + row * 768 + col) : (proj + row * 3072 + (col - 768));
                        *(u32x4*)d = o;
                        if (upn >= 3 && upn < 9) {
                            if (fr == 0 && m == 0) *(u32x4*)(halo + ((row >> 6) * 2) * 1536 + (col - 768)) = o;
                            if (fr == 15 && m == 3) *(u32x4*)(halo + ((row >> 6) * 2 + 1) * 1536 + (col - 768)) = o;
                        }
                    }
                }
            }
    }
};
struct EpiRes {
    static constexpr bool PERM = false;
    const float* src_lat; const float* src_ctx; float* dst_lat; float* dst_ctx; const float* gate;
    float* slab;
    __device__ __forceinline__ void operator()(const f32x4 (&acc)[2][2][4][2], const int upm, const int upn, const int usplit, int wr, int wc, int fr, int fq) const {
        const int row0 = upm * BM + wr * 64 + fr, col0 = upn * BM + wc * 32 + 4 * fq;
        if (usplit) {
            float* sl = slab + ((size_t)(usplit - 1) * NCTX + (row0 - NLAT)) * DM + col0;
#pragma unroll
            for (int ai = 0; ai < 2; ++ai)
#pragma unroll
                for (int m = 0; m < 4; ++m)
#pragma unroll
                    for (int bj = 0; bj < 2; ++bj)
#pragma unroll
                        for (int n = 0; n < 2; ++n) *(f32x4*)(sl + (size_t)(ai * HALF + m * 16) * DM + bj * HALF + n * 16) = acc[ai][bj][m][n];
            return;
        }
        const bool lat = upm * BM < NLAT; const int b = lat ? ((upm * BM) >> 11) : 16;
        const float* gp = gate + (size_t)b * 6144 + col0;
        f32x4 gv[2][2];
#pragma unroll
        for (int bj = 0; bj < 2; ++bj)
#pragma unroll
            for (int n = 0; n < 2; ++n) gv[bj][n] = *(const f32x4*)(gp + bj * HALF + n * 16);
        const float* sb = lat ? src_lat : src_ctx - (size_t)NLAT * DM; float* db = lat ? dst_lat : dst_ctx - (size_t)NLAT * DM;
#pragma unroll
        for (int ai = 0; ai < 2; ++ai)
#pragma unroll
            for (int mh = 0; mh < 2; ++mh) {
                f32x4 xv[2][2][2];
#pragma unroll
                for (int m = 0; m < 2; ++m)
#pragma unroll
                    for (int bj = 0; bj < 2; ++bj)
#pragma unroll
                        for (int n = 0; n < 2; ++n) xv[m][bj][n] = *(const f32x4*)(sb + (size_t)(row0 + ai * HALF + (mh * 2 + m) * 16) * DM + col0 + bj * HALF + n * 16);
                __builtin_amdgcn_sched_barrier(0);
#pragma unroll
                for (int m = 0; m < 2; ++m)
#pragma unroll
                    for (int bj = 0; bj < 2; ++bj)
#pragma unroll
                        for (int n = 0; n < 2; ++n) *(f32x4*)(db + (size_t)(row0 + ai * HALF + (mh * 2 + m) * 16) * DM + col0 + bj * HALF + n * 16) = xv[m][bj][n] + gv[bj][n] * acc[ai][bj][mh * 2 + m][n];
            }
    }
};
struct EpiSwiglu {
    static constexpr bool PERM = true;
    bf16_t* hid;
    __device__ __forceinline__ void operator()(const f32x4 (&acc)[2][2][4][2], const int upm, const int upn, const int usplit, int wr, int wc, int fr, int fq) const {
        const int row0 = upm * BM + wr * 64 + fr, col = upn * 128 + wc * 32 + 8 * fq;
#pragma unroll
        for (int ai = 0; ai < 2; ++ai)
#pragma unroll
            for (int m = 0; m < 4; ++m) {
                const size_t row = (size_t)(row0 + ai * HALF + m * 16);
                float r[8];
#pragma unroll
                for (int n = 0; n < 2; ++n)
#pragma unroll
                    for (int j = 0; j < 4; ++j) { const float gv = acc[ai][0][m][n][j], uv = acc[ai][1][m][n][j]; r[n * 4 + j] = gv * __builtin_amdgcn_rcpf(1.f + __expf(-gv)) * uv; }
                u32x4 o; o.x = cvt_pk_bf16(r[0], r[1]); o.y = cvt_pk_bf16(r[2], r[3]); o.z = cvt_pk_bf16(r[4], r[5]); o.w = cvt_pk_bf16(r[6], r[7]);
                *(u32x4*)(hid + row * FFH + col) = o;
            }
    }
};
}

__device__ __forceinline__ int wt_map(int mode, int n) {
    if (mode == 1) return n < 2816 ? n : (n < 2832 ? 3840 + (n - 2816) : n - 16);
    if (mode == 2) { const int j = n < FFH ? n : n - FFH; return (j >> 7) * 256 + (n < FFH ? 0 : 128) + (j & 127); }
    return n;
}
__device__ NOINL void prep_weights(const LAS Params* lp, int l, LAS unsigned char* lds, int first = 0) {
    Params p; LP(w_in); LP(w_out); LP(ffn_w_in); LP(ffn_w_out); LP(Wt_in); LP(Wt_out); LP(Wt_f1); LP(Wt_f2);
    const int tid = otid();
    const int I0 = 16 * 16, I1 = 16 * 4, I2 = 16 * 22, I3 = 44 * 4, NI = I0 + I1 + I2 + I3;
    const float* W; bf16_t* Wt; int K, N, mode, k0, n0;
    auto resolve = [&](int it) {
        int r = it;
        if (r < I0) { W = p.w_in + (size_t)l * DM * INW; K = DM; N = INW; Wt = p.Wt_in; mode = 1; }
        else if ((r -= I0) < I1) { W = p.w_out + (size_t)l * DM * DM; K = DM; N = DM; Wt = p.Wt_out; mode = 0; }
        else if ((r -= I1) < I2) { W = p.ffn_w_in + (size_t)l * DM * 2 * FFH; K = DM; N = 2 * FFH; Wt = p.Wt_f1; mode = 2; }
        else { r -= I2; W = p.ffn_w_out + (size_t)l * FFH * DM; K = FFH; N = DM; Wt = p.Wt_f2; mode = 0; }
        const int ntn = (N + 255) / 256; k0 = (r / ntn) * 64; n0 = (r % ntn) * 256;
    };
    f32x4 v[2][4];
    auto issue = [&]() {
#pragma unroll
        for (int pass = 0; pass < 2; ++pass)
#pragma unroll
            for (int q = 0; q < 4; ++q) {
                const int kk = pass * 32 + (tid >> 4), nn = q * 64 + (tid & 15) * 4;
                v[pass][q] = (n0 + nn < N) ? *(const f32x4*)(W + (size_t)(k0 + kk) * N + n0 + nn) : (f32x4){0.f, 0.f, 0.f, 0.f};
            }
    };
    int it = first + blockIdx.x, buf = 0;
    __syncthreads();
    if (it < NI) { resolve(it); issue(); }
    for (; it < NI; it += gridDim.x) {
        LAS bf16_t* ts = (LAS bf16_t*)(lds + buf * 36864);
#pragma unroll
        for (int pass = 0; pass < 2; ++pass)
#pragma unroll
            for (int q = 0; q < 4; ++q) {
                const int kk = pass * 32 + (tid >> 4), nn = q * 64 + (tid & 15) * 4;
                ts[(nn + 0) * 72 + kk] = f2bf(v[pass][q][0]); ts[(nn + 1) * 72 + kk] = f2bf(v[pass][q][1]); ts[(nn + 2) * 72 + kk] = f2bf(v[pass][q][2]); ts[(nn + 3) * 72 + kk] = f2bf(v[pass][q][3]);
            }
        const int nn = tid >> 1, k32 = (tid & 1) * 32;
        const bool ok = n0 + nn < N;
        bf16_t* d = Wt + (size_t)wt_map(mode, ok ? n0 + nn : 0) * K + k0 + k32;
        if (it + (int)gridDim.x < NI) { resolve(it + gridDim.x); issue(); }
        __syncthreads();
        if (ok) {
#pragma unroll
            for (int q = 0; q < 4; ++q) *(u32x4*)(d + q * 8) = *(const LAS u32x4*)(ts + nn * 72 + k32 + q * 8);
        }
        buf ^= 1;
    }
    u32x4 z = {0u, 0u, 0u, 0u};
    for (size_t i = (size_t)blockIdx.x * 512 + tid; i < (size_t)240 * DM / 8; i += (size_t)gridDim.x * 512) *(u32x4*)(p.Wt_in + (size_t)3856 * DM + i * 8) = z;
}
__device__ NOINL void prep_mod(const LAS Params* lp, LAS unsigned char* lds) {
    Params p; LP(c); LP(c_ctx); LP(mod_w); LP(mod_b); LP(modbuf);
    LAS float* sc = (LAS float*)lds;
    LAS float* red = (LAS float*)(lds + 17 * 1024 * 4);
    const int tid = otid(), w = tid >> 6, lane = tid & 63;
    bool have = false;
    for (int it = blockIdx.x; it < 2 * 96; it += gridDim.x) {
        const int l = it / 96, n0 = (it % 96) * 64;
        __syncthreads();
        if (!have) { for (int i = tid; i < 17 * 1024; i += 512) { const float v = i < 16 * 1024 ? p.c[i] : p.c_ctx[i - 16 * 1024]; sc[i] = siluf(v); } have = true; __syncthreads(); }
        float acc[17];
#pragma unroll
        for (int r = 0; r < 17; ++r) acc[r] = 0.f;
        const float* wp = p.mod_w + (size_t)l * DM * 6144 + n0 + lane;
#pragma unroll 4
        for (int k = w * 128; k < w * 128 + 128; k += 4) {
            const float w0 = wp[(size_t)k * 6144], w1 = wp[(size_t)(k + 1) * 6144], w2 = wp[(size_t)(k + 2) * 6144], w3 = wp[(size_t)(k + 3) * 6144];
#pragma unroll
            for (int r = 0; r < 17; ++r) { const f32x4 sv = *(const LAS f32x4*)(sc + r * 1024 + k); acc[r] += sv[0] * w0 + sv[1] * w1 + sv[2] * w2 + sv[3] * w3; }
        }
#pragma unroll
        for (int r = 0; r < 17; ++r) red[(w * 17 + r) * 64 + lane] = acc[r];
        __syncthreads();
        for (int i = tid; i < 17 * 64; i += 512) {
            const int r = i >> 6, nn = i & 63; float s = p.mod_b[l * 6144 + n0 + nn];
#pragma unroll
            for (int ww = 0; ww < 8; ++ww) s += red[(ww * 17 + r) * 64 + nn];
            p.modbuf[((size_t)l * 17 + r) * 6144 + n0 + nn] = s;
        }
    }
}
__device__ NOINL void prep_filters(const LAS Params* lp, int l, bool with_ctx, LAS unsigned char* lds) {
    Params p; LP(hy_f_w1); LP(hy_f_b1); LP(hy_f_freq1); LP(hy_f_w2); LP(hy_f_b2); LP(hy_f_freq2); LP(hy_f_w3); LP(Fl); LP(Fc);
    LAS float* zz = (LAS float*)lds;
    LAS float* h1 = zz + 8 * 33;
    LAS float* h2 = h1 + 8 * 64;
    const int tid = otid();
    const float* w1 = p.hy_f_w1 + l * 33 * 64; const float* b1 = p.hy_f_b1 + l * 64; const float* f1 = p.hy_f_freq1 + l * 64;
    const float* w2 = p.hy_f_w2 + l * 64 * 64; const float* b2 = p.hy_f_b2 + l * 64; const float* f2 = p.hy_f_freq2 + l * 64;
    const float* w3 = p.hy_f_w3 + (size_t)l * 64 * 1024;
    const int nit = with_ctx ? 288 : 256;
    for (int it = (blockIdx.x + 64) % gridDim.x; it < nit; it += gridDim.x) {
        const bool isc = it >= 256; const int L = isc ? CTXL : SEQ; const int p0 = (isc ? it - 256 : it) * 8;
        bf16_t* F = isc ? p.Fc : p.Fl;
        __syncthreads();
        if (tid < 264) {
            const int pp = tid / 33, e = tid % 33; const float pos = (float)(p0 + pp);
            float v;
            if (e == 0) v = pos / (float)(L - 1);
            else { const int k = (e - 1) & 15; const float fk = 1e-4f + (float)k * ((15.f - 1e-4f) / 15.f); const float ang = (6.283185307179586f / (float)L) * pos * fk; v = e <= 16 ? cosf(ang) : -sinf(ang); }
            zz[pp * 33 + e] = v;
        }
        __syncthreads();
        { const int pp = tid >> 6, j = tid & 63; float s = b1[j];
#pragma unroll 3
          for (int e = 0; e < 33; ++e) s += zz[pp * 33 + e] * w1[e * 64 + j];
          h1[pp * 64 + j] = sinf(f1[j] * s); }
        __syncthreads();
        { const int pp = tid >> 6, j = tid & 63; float s = b2[j];
#pragma unroll 4
          for (int e = 0; e < 64; ++e) s += h1[pp * 64 + e] * w2[e * 64 + j];
          h2[pp * 64 + j] = sinf(f2[j] * s); }
        __syncthreads();
#pragma unroll 1
        for (int cc = 0; cc < 2; ++cc) {
            const int col = tid + cc * 512;
            float acc[8];
#pragma unroll
            for (int pp = 0; pp < 8; ++pp) acc[pp] = 0.f;
#pragma unroll 4
            for (int j = 0; j < 64; ++j) { const float wv = w3[j * 1024 + col];
#pragma unroll
                for (int pp = 0; pp < 8; ++pp) acc[pp] += h2[pp * 64 + j] * wv; }
            const int order = col >> 9, side = (col >> 8) & 1, c = col & 255;
            const float delta = 3.0701134573253945f + (float)c * ((15.350567286626973f - 3.0701134573253945f) / 255.f);
            bf16_t* Fr = F + ((size_t)order * 256 + c) * (2 * L);
#pragma unroll
            for (int pp = 0; pp < 8; ++pp) {
                const int pos = p0 + pp; const float tpos = (float)pos / (float)(L - 1);
                const float v = acc[pp] * __expf(-tpos * delta);
                if (side == 0) Fr[L - pos] = f2bf(v);
                else if (pos > 0) Fr[L + pos] = f2bf(v);
                else Fr[0] = 0;
            }
        }
    }
}

__device__ NOINL void norm_mod_phase(const float* lat, const float* ctxp, int nrows, const float* g, const float* mod  , int si, bf16_t* hb,
                                     const float* slab = nullptr  , const float* sgate = nullptr  , float* wb = nullptr  ) {
    const int tid = otid(), w = tid >> 6, lane = tid & 63;
    const int stride = gridDim.x * 8;
    for (int row = blockIdx.x * 8 + w; row < nrows; row += 2 * stride) {
        f32x4 v[2][4]; float ss[2] = {0.f, 0.f}; int rows[2] = {row, row + stride};
#pragma unroll
        for (int u = 0; u < 2; ++u) {
            if (rows[u] < nrows) {
                const bool il = rows[u] < NLAT;
                const float* xr = il ? lat + (size_t)rows[u] * DM : ctxp + (size_t)(rows[u] - NLAT) * DM;
#pragma unroll
                for (int j = 0; j < 4; ++j) v[u][j] = *(const f32x4*)(xr + 4 * lane + 256 * j);
                if (!il && slab) {
                    const size_t ro = (size_t)(rows[u] - NLAT) * DM;
#pragma unroll
                    for (int j = 0; j < 4; ++j) {
                        const int c = 4 * lane + 256 * j;
                        const f32x4 s0 = *(const f32x4*)(slab + ro + c), s1 = *(const f32x4*)(slab + (size_t)NCTX * DM + ro + c), s2 = *(const f32x4*)(slab + (size_t)2 * NCTX * DM + ro + c), s3 = *(const f32x4*)(slab + (size_t)3 * NCTX * DM + ro + c);
                        v[u][j] += *(const f32x4*)(sgate + c) * ((s0 + s1) + (s2 + s3));
                        if (wb) *(f32x4*)(wb + ro + c) = v[u][j];
                    }
                }
            }
        }
#pragma unroll
        for (int u = 0; u < 2; ++u) {
            if (rows[u] < nrows) {
#pragma unroll
                for (int j = 0; j < 4; ++j) ss[u] += v[u][j][0] * v[u][j][0] + v[u][j][1] * v[u][j][1] + v[u][j][2] * v[u][j][2] + v[u][j][3] * v[u][j][3];
                const float inv = rsqrtf(wave_sum(ss[u]) * (1.f / DM) + 1e-6f);
                const int b = rows[u] < NLAT ? (rows[u] >> 11) : 16;
                const float* sh = mod + (size_t)b * 6144 + si * 1024; const float* scp = sh + 1024;
#pragma unroll
                for (int j = 0; j < 4; ++j) {
                    const int c = 4 * lane + 256 * j;
                    const f32x4 gv = *(const f32x4*)(g + c), sv = *(const f32x4*)(scp + c), hv = *(const f32x4*)(sh + c);
                    float o[4];
#pragma unroll
                    for (int e = 0; e < 4; ++e) o[e] = v[u][j][e] * inv * gv[e] * (1.f + sv[e]) + hv[e];
                    u32x2 pk; pk.x = pk2(o[0], o[1]); pk.y = pk2(o[2], o[3]);
                    *(u32x2*)(hb + (size_t)rows[u] * DM + c) = pk;
                }
            }
        }
    }
}
__device__ NOINL void final_norm_phase(float* xo, const float* g) {
    const int tid = otid(), w = tid >> 6, lane = tid & 63;
    for (int row = blockIdx.x * 8 + w; row < NLAT; row += gridDim.x * 8) {
        float* xr = xo + (size_t)row * DM;
        f32x4 v[4]; float ss = 0.f;
#pragma unroll
        for (int j = 0; j < 4; ++j) { v[j] = *(const f32x4*)(xr + 4 * lane + 256 * j); ss += v[j][0] * v[j][0] + v[j][1] * v[j][1] + v[j][2] * v[j][2] + v[j][3] * v[j][3]; }
        const float inv = rsqrtf(wave_sum(ss) * (1.f / DM) + 1e-6f);
#pragma unroll
        for (int j = 0; j < 4; ++j) { const int c = 4 * lane + 256 * j; const f32x4 gv = *(const f32x4*)(g + c); *(f32x4*)(xr + c) = v[j] * inv * gv; }
    }
}

#define XB_TMO      128
#define XB_XCNT(j)  (256  + 64 * (j))
#define XB_XSUB(j)  (1280 + 64 * (j))
#define XB_XGEN(j)  (2304 + 64 * (j))
#define XB_TOP      3328
#define XB_TOPGEN   3392
#define XCD_BAR_WORDS 3456
#define XB_SPIN_CAP (1u << 18)
__device__ __forceinline__ unsigned xb_ld(unsigned* p)              { return __hip_atomic_load(p, __ATOMIC_RELAXED, __HIP_MEMORY_SCOPE_AGENT); }
__device__ __forceinline__ unsigned xb_add(unsigned* p, unsigned v) { return __hip_atomic_fetch_add(p, v, __ATOMIC_RELAXED, __HIP_MEMORY_SCOPE_AGENT); }
__device__ __forceinline__ unsigned xb_xcc_id() { return (unsigned)__builtin_amdgcn_s_getreg((3 << 11) | 20) & 0xFu; }
#define XB_SPIN(cond, bar) do { unsigned _sp = 0; while (cond) { __builtin_amdgcn_s_sleep(1); \
    if ((++_sp & 255u) == 0u) { if (xb_ld(&(bar)[XB_TMO])) break; if (_sp > XB_SPIN_CAP) { atomicAdd(&(bar)[XB_TMO], 1u); break; } } } } while (0)
struct XcdBarrier { unsigned* bar; unsigned x; volatile LAS unsigned* st; };
__device__ __forceinline__ XcdBarrier xcd_barrier_post(unsigned* bar, volatile LAS unsigned* st) {
    XcdBarrier b; b.bar = bar; b.x = xb_xcc_id(); b.st = st;
    if (threadIdx.x == 0) (void)xb_add(&bar[XB_XCNT(b.x)], 1u);
    return b;
}
__device__ __forceinline__ void xcd_barrier_complete(unsigned* bar, unsigned x, unsigned& nloc, unsigned& nx) {
    const unsigned G = gridDim.x * gridDim.y * gridDim.z;
    unsigned sum, cnt, mine, sp = 0u;
    for (;;) {
        sum = 0u; cnt = 0u; mine = 0u;
#pragma unroll
        for (unsigned j = 0; j < 16; ++j) { const unsigned c = xb_ld(&bar[XB_XCNT(j)]); sum += c; cnt += (c > 0u) ? 1u : 0u; mine = (j == x) ? c : mine; }
        if (sum == G) break;
        __builtin_amdgcn_s_sleep(1);
        if ((++sp & 255u) == 0u) { if (xb_ld(&bar[XB_TMO])) break; if (sp > XB_SPIN_CAP) { atomicAdd(&bar[XB_TMO], 1u); break; } }
    }
    nloc = mine > 0u ? mine : 1u; nx = cnt > 0u ? cnt : 1u;
}
__device__ __forceinline__ void xcd_barrier(const XcdBarrier& b) {
    asm volatile("s_waitcnt vmcnt(0)" ::: "memory");
    __syncthreads();
    if (threadIdx.x == 0) {
        unsigned* bar = b.bar;
        __builtin_amdgcn_s_waitcnt(0);
        unsigned nloc = b.st[0], nx = b.st[1];
        if (nloc == 0u) { xcd_barrier_complete(bar, b.x, nloc, nx); b.st[0] = nloc; b.st[1] = nx; }
        const unsigned old = xb_add(&bar[XB_XSUB(b.x)], 1u);
        const unsigned gen = old / nloc;
        if (old + 1u == (gen + 1u) * nloc) {
            __builtin_amdgcn_fence(__ATOMIC_RELEASE, "agent");
            asm volatile("s_waitcnt vmcnt(0)" ::: "memory");
            const unsigned og = xb_add(&bar[XB_TOP], 1u);
            const unsigned tg = og / nx;
            if (og + 1u == (tg + 1u) * nx) xb_add(&bar[XB_TOPGEN], 1u);
            else XB_SPIN(xb_ld(&bar[XB_TOPGEN]) == tg, bar);
            __builtin_amdgcn_fence(__ATOMIC_ACQUIRE, "agent");
            xb_add(&bar[XB_XGEN(b.x)], 1u);
            asm volatile("s_waitcnt vmcnt(0)" ::: "memory");
        } else {
            XB_SPIN(xb_ld(&bar[XB_XGEN(b.x)]) == gen, bar);
            __builtin_amdgcn_fence(__ATOMIC_ACQUIRE, "agent");
            asm volatile("s_waitcnt vmcnt(0)" ::: "memory");
        }
    }
    __syncthreads();
}

__device__ NOINL void prep_rope(const LAS Params* lp) {
    Params p; LP(ropeT);
    for (int i = blockIdx.x * 512 + otid(); i < SEQ * 32; i += gridDim.x * 512) {
        const int t = i >> 5, a = i & 31;
        const float inv = exp2f(-(float)(a & 15) * (13.287712379549449f / 16.f));
        const float ang = (a < 16 ? (float)(t >> 6) : (float)(t & 63)) * inv;
        float sn, cs; sincosf(ang, &sn, &cs);
        p.ropeT[2 * i] = cs; p.ropeT[2 * i + 1] = sn;
    }
}

__device__ NOINL void h1_phase(const LAS Params* lp, int l, bool with_ctx, LAS unsigned char* lds) {
    Params p; LP(hy_conv_w); LP(hy_conv_b); LP(hyproj); LP(hyT); LP(hyTc);
    LAS float* cwl = (LAS float*)(lds + 73728);
    const int tid = otid();
    __syncthreads();
    for (int i = tid; i < 4 * 768; i += 512) cwl[i] = i < 2304 ? p.hy_conv_w[l * 2304 + i] : p.hy_conv_b[l * 768 + i - 2304];
    __syncthreads();
    const int nit = ((with_ctx ? NTOK : NLAT) / 64) * 3;
    const int tk = tid >> 3, c8 = (tid & 7) * 8;
    u32x4 r0[4], r1[4], r2[4];
    auto issue = [&](int it) {
        const int tt = it / 3, c0 = (it % 3) * 256, row0 = tt * 64;
        const bool il = row0 < NLAT; const int L = il ? SEQ : CTXL;
        const int t = (il ? row0 % SEQ : (row0 - NLAT) % CTXL) + tk;
        const u32x4 z = {0u, 0u, 0u, 0u};
#pragma unroll
        for (int q = 0; q < 4; ++q) {
            const bf16_t* src = p.hyproj + (size_t)(row0 + tk) * 768 + c0 + q * 64 + c8;
            r0[q] = t > 0 ? *(const u32x4*)(src - 768) : z; r1[q] = *(const u32x4*)src; r2[q] = t < L - 1 ? *(const u32x4*)(src + 768) : z;
        }
    };
    int it = blockIdx.x, buf = 0;
    if (it < nit) issue(it);
    for (; it < nit; it += gridDim.x) {
        const int tt = it / 3, c0 = (it % 3) * 256, row0 = tt * 64;
        const bool il = row0 < NLAT;
        const int b = il ? row0 / SEQ : (row0 - NLAT) / CTXL, t0 = il ? row0 % SEQ : (row0 - NLAT) % CTXL;
        LAS bf16_t* ts = (LAS bf16_t*)(lds + buf * 36864);
#pragma unroll
        for (int q = 0; q < 4; ++q) {
            const int ch = c0 + q * 64 + c8;
            float a0[8], a1[8], a2[8]; unpack8(r0[q], a0); unpack8(r1[q], a1); unpack8(r2[q], a2);
#pragma unroll
            for (int e4 = 0; e4 < 2; ++e4) {
                const f32x4 w0 = *(const LAS f32x4*)(cwl + ch + e4 * 4), w1 = *(const LAS f32x4*)(cwl + 768 + ch + e4 * 4), w2 = *(const LAS f32x4*)(cwl + 1536 + ch + e4 * 4), wb = *(const LAS f32x4*)(cwl + 2304 + ch + e4 * 4);
#pragma unroll
                for (int u = 0; u < 4; ++u) { const int e = e4 * 4 + u; ts[(q * 64 + c8 + e) * 72 + tk] = f2bf(w0[u] * a0[e] + w1[u] * a1[e] + w2[u] * a2[e] + wb[u]); }
            }
        }
        if (it + (int)gridDim.x < nit) issue(it + gridDim.x);
        __syncthreads();
        {
            const int chl = tid >> 1, hf = tid & 1;
            bf16_t* dst = il ? p.hyT + ((size_t)(c0 + chl) * NB + b) * SEQ + t0 + hf * 32 : p.hyTc + ((size_t)(c0 + chl) * NB + b) * CTXL + t0 + hf * 32;
#pragma unroll
            for (int q = 0; q < 4; ++q) *(u32x4*)(dst + q * 8) = *(const LAS u32x4*)(ts + chl * 72 + hf * 32 + q * 8);
        }
        buf ^= 1;
    }
}

__device__ __forceinline__ void chunk_geom(int b, int cid, int& row0, int& t0, int& L) {
    if (cid < 4) { row0 = NLAT + b * CTXL + cid * 64; t0 = cid * 64; L = CTXL; } else { row0 = b * SEQ + (cid - 4) * 64; t0 = (cid - 4) * 64; L = SEQ; }
}
__device__ __forceinline__ void conv16p(const bf16_t* pc, const bf16_t* pp, const bf16_t* pn, const LAS float* w  , float* out) {
    const u32x4 z = {0u, 0u, 0u, 0u};
#pragma unroll
    for (int hh = 0; hh < 2; ++hh) {
        const u32x4 r0 = pp ? *(const u32x4*)(pp + hh * 8) : z, r1 = *(const u32x4*)(pc + hh * 8), r2 = pn ? *(const u32x4*)(pn + hh * 8) : z;
        float a0[8], a1[8], a2[8]; unpack8(r0, a0); unpack8(r1, a1); unpack8(r2, a2);
#pragma unroll
        for (int q = 0; q < 2; ++q) {
            const f32x4 w0 = *(const LAS f32x4*)(w + hh * 8 + q * 4), w1 = *(const LAS f32x4*)(w + 128 + hh * 8 + q * 4), w2 = *(const LAS f32x4*)(w + 256 + hh * 8 + q * 4);
#pragma unroll
            for (int e = 0; e < 4; ++e) out[hh * 8 + q * 4 + e] = w0[e] * a0[q * 4 + e] + w1[e] * a1[q * 4 + e] + w2[e] * a2[q * 4 + e];
        }
    }
}
__device__ __forceinline__ void pack16(const float* v, float sc, u32x4& o0, u32x4& o1) {
    o0.x = pk2(v[0] * sc, v[1] * sc); o0.y = pk2(v[2] * sc, v[3] * sc); o0.z = pk2(v[4] * sc, v[5] * sc); o0.w = pk2(v[6] * sc, v[7] * sc);
    o1.x = pk2(v[8] * sc, v[9] * sc); o1.y = pk2(v[10] * sc, v[11] * sc); o1.z = pk2(v[12] * sc, v[13] * sc); o1.w = pk2(v[14] * sc, v[15] * sc);
}

__device__ NOINL void qkvn_phase(const LAS Params* lp, int l, LAS unsigned char* lds) {
    Params p; LP(proj); LP(halo); LP(gdn_conv_w); LP(ropeT);
    const int tid = otid(), tk = tid >> 3, cg8 = tid & 7;
    const float* gcw = p.gdn_conv_w + (size_t)l * 3 * 1536;
    constexpr int NT = NTOK / 64;
    LAS float* cwl = (LAS float*)(lds + 86016);
    int curh = -1;
    u32x4 raw[3][3][2];
    auto issue = [&](int it, int tn) {
        const int tt = it >> 2, h = it & 3, row0 = tt * 64;
        const bool il = row0 < NLAT; const int L = il ? SEQ : CTXL; const int t = (il ? row0 % SEQ : (row0 - NLAT) % CTXL) + tk;
        const int col = tn * 512 + h * 128 + cg8 * 16;
        const bf16_t* pc = p.proj + (size_t)(row0 + tk) * 3072 + col;
        const bf16_t* pp = tk > 0 ? pc - 3072 : (t > 0 ? p.halo + ((size_t)(tt - 1) * 2 + 1) * 1536 + col : nullptr);
        const bf16_t* pn = tk < 63 ? pc + 3072 : (t < L - 1 ? p.halo + ((size_t)(tt + 1) * 2) * 1536 + col : nullptr);
        const u32x4 z = {0u, 0u, 0u, 0u};
#pragma unroll
        for (int hh = 0; hh < 2; ++hh) { raw[tn][0][hh] = pp ? *(const u32x4*)(pp + hh * 8) : z; raw[tn][1][hh] = *(const u32x4*)(pc + hh * 8); raw[tn][2][hh] = pn ? *(const u32x4*)(pn + hh * 8) : z; }
    };
    int it = blockIdx.x;
    if (it < NT * 4) { issue(it, 0); issue(it, 1); issue(it, 2); }
    for (; it < NT * 4; it += gridDim.x) {
        const int tt = it >> 2, h = it & 3, row0 = tt * 64;
        if (h != curh) {
            __syncthreads();
            for (int i = tid; i < 1152; i += 512) { const int tn = i / 384, j = (i / 128) % 3, cc = i & 127; cwl[i] = gcw[j * 1536 + tn * 512 + h * 128 + cc]; }
            __syncthreads();
            curh = h;
        }
        const bool more = it + (int)gridDim.x < NT * 4;
        u32x4 o[3][2];
#pragma unroll
        for (int tn = 0; tn < 3; ++tn) {
            float v[16];
            const LAS float* w = cwl + tn * 384 + cg8 * 16;
#pragma unroll
            for (int hh = 0; hh < 2; ++hh) {
                float a0[8], a1[8], a2[8]; unpack8(raw[tn][0][hh], a0); unpack8(raw[tn][1][hh], a1); unpack8(raw[tn][2][hh], a2);
#pragma unroll
                for (int q = 0; q < 2; ++q) {
                    const f32x4 w0 = *(const LAS f32x4*)(w + hh * 8 + q * 4), w1 = *(const LAS f32x4*)(w + 128 + hh * 8 + q * 4), w2 = *(const LAS f32x4*)(w + 256 + hh * 8 + q * 4);
#pragma unroll
                    for (int e = 0; e < 4; ++e) v[hh * 8 + q * 4 + e] = w0[e] * a0[q * 4 + e] + w1[e] * a1[q * 4 + e] + w2[e] * a2[q * 4 + e];
                }
            }
            if (more) issue(it + gridDim.x, tn);
            float ss = 0.f;
#pragma unroll
            for (int e = 0; e < 16; ++e) { v[e] = siluf(v[e]); ss += v[e] * v[e]; }
            float sc = 1.f;
            if (tn < 2) { ss += __shfl_xor(ss, 1); ss += __shfl_xor(ss, 2); ss += __shfl_xor(ss, 4); sc = rsqrtf(ss + 1e-6f) * (tn == 0 ? 0.08838834764831845f : 1.f); }
            pack16(v, sc, o[tn][0], o[tn][1]);
        }
        __syncthreads();
#pragma unroll
        for (int tn = 0; tn < 3; ++tn) { bf16_t* d = p.proj + (size_t)(row0 + tk) * 3072 + tn * 512 + h * 128 + cg8 * 16; *(u32x4*)d = o[tn][0]; *(u32x4*)(d + 8) = o[tn][1]; }
    }
    for (int tt = blockIdx.x; tt < NT; tt += gridDim.x) {
        const int row0 = tt * 64, hd = cg8 >> 1, i0 = (cg8 & 1) * 16;
        const bool il = row0 < NLAT; const int t = (row0 % SEQ) + tk;
        bf16_t* qp = p.proj + (size_t)(row0 + tk) * 3072 + 2048 + hd * 64 + i0; bf16_t* kp = qp + 256;
        float q1[16], q2[16], k1[16], k2[16];
        unpack8(*(const u32x4*)qp, q1); unpack8(*(const u32x4*)(qp + 8), q1 + 8); unpack8(*(const u32x4*)(qp + 32), q2); unpack8(*(const u32x4*)(qp + 40), q2 + 8);
        unpack8(*(const u32x4*)kp, k1); unpack8(*(const u32x4*)(kp + 8), k1 + 8); unpack8(*(const u32x4*)(kp + 32), k2); unpack8(*(const u32x4*)(kp + 40), k2 + 8);
        float qa[16], qb[16], ka[16], kb[16];
#pragma unroll
        for (int e2 = 0; e2 < 8; ++e2) {
            f32x4 cs4 = {1.f, 0.f, 1.f, 0.f};
            if (il) cs4 = *(const f32x4*)(p.ropeT + ((size_t)t * 32 + i0 + 2 * e2) * 2);
#pragma unroll
            for (int u = 0; u < 2; ++u) {
                const int e = 2 * e2 + u; const float cs = cs4[2 * u], sn = cs4[2 * u + 1];
                qa[e] = q1[e] * cs - q2[e] * sn; qb[e] = q1[e] * sn + q2[e] * cs;
                ka[e] = (k1[e] * cs - k2[e] * sn) * 0.125f; kb[e] = (k1[e] * sn + k2[e] * cs) * 0.125f;
            }
        }
        u32x4 o0, o1;
        pack16(qa, 1.f, o0, o1); *(u32x4*)qp = o0; *(u32x4*)(qp + 8) = o1;
        pack16(qb, 1.f, o0, o1); *(u32x4*)(qp + 32) = o0; *(u32x4*)(qp + 40) = o1;
        pack16(ka, 1.f, o0, o1); *(u32x4*)kp = o0; *(u32x4*)(kp + 8) = o1;
        pack16(kb, 1.f, o0, o1); *(u32x4*)(kp + 32) = o0; *(u32x4*)(kp + 40) = o1;
    }
}

__device__ NOINL void g1_phase(const LAS Params* lp, int l, LAS unsigned char* lds) {
    Params p; LP(proj); LP(ab); LP(gdn_a_log); LP(gdn_dt_bias); LP(Tbuf); LP(gcbuf);
    constexpr int SLOT = 51200;
    const int tid = otid(), w = tid >> 6, lane = tid & 63, fr = lane & 15, fq = lane >> 4;
    for (int it = blockIdx.x; it < NB * 4 * 12; it += gridDim.x) {
        const int b = it / 48, h = (it / 12) & 3, c3 = it % 12;
        __syncthreads();
        {
            const int tk = tid >> 3, cg8 = tid & 7;
#pragma unroll
            for (int s = 0; s < 3; ++s) {
                int row0, t0, L; chunk_geom(b, c3 * 3 + s, row0, t0, L);
                const bf16_t* src = p.proj + (size_t)(row0 + tk) * 3072 + 512 + h * 128 + cg8 * 16;
                LAS bf16_t* Kn = (LAS bf16_t*)(lds + s * SLOT);
                *(LAS u32x4*)(Kn + tk * 136 + cg8 * 16) = *(const u32x4*)src; *(LAS u32x4*)(Kn + tk * 136 + cg8 * 16 + 8) = *(const u32x4*)(src + 8);
            }
        }
        if (w < 6) {
            const int s = w >> 1, dir = w & 1, tk = dir ? 63 - lane : lane;
            int row0, t0, L; chunk_geom(b, c3 * 3 + s, row0, t0, L);
            const float a = p.ab[(size_t)(row0 + tk) * 16 + dir * 4 + h], bb = p.ab[(size_t)(row0 + tk) * 16 + 8 + dir * 4 + h];
            float g = -__expf(p.gdn_a_log[l * 8 + dir * 4 + h]) * softplusf(a + p.gdn_dt_bias[l * 8 + dir * 4 + h]);
#pragma unroll
            for (int o = 1; o < 64; o <<= 1) { const float t = __shfl_up(g, o); if (lane >= o) g += t; }
            LAS float* gcs = (LAS float*)(lds + s * SLOT + 17408);
            const float be = __builtin_amdgcn_rcpf(1.f + __expf(-bb));
            gcs[dir * 64 + lane] = g; gcs[128 + dir * 64 + lane] = be;
            float* gb = p.gcbuf + ((((size_t)b * 4 + h) * 36 + c3 * 3 + s) * 2 + dir) * 192;
            gb[lane] = g; gb[64 + lane] = be; gb[128 + lane] = __expf(g);
        }
        __syncthreads();
#pragma unroll 1
        for (int q = 0; q < 6; ++q) {
            const int tix = w * 6 + q, s = tix >> 4, itl = (tix >> 2) & 3, jt = tix & 3;
            const LAS bf16_t* Kn = (const LAS bf16_t*)(lds + s * SLOT);
            const LAS float* gcs = (const LAS float*)(lds + s * SLOT + 17408);
            LAS float* Lm = (LAS float*)(lds + s * SLOT + 18432);
            f32x4 acc = {0.f, 0.f, 0.f, 0.f};
#pragma unroll
            for (int ks = 0; ks < 4; ++ks) {
                const bf16x8 A = *(const LAS bf16x8*)(Kn + (16 * itl + fr) * 136 + ks * 32 + fq * 8), B = *(const LAS bf16x8*)(Kn + (16 * jt + fr) * 136 + ks * 32 + fq * 8);
                acc = MFMA16(A, B, acc);
            }
            const int jj = 16 * jt + fr;
#pragma unroll
            for (int j = 0; j < 4; ++j) {
                const int i = 16 * itl + 4 * fq + j;
                const float v0 = jj < i ? gcs[128 + i] * acc[j] * __expf(gcs[i] - gcs[jj]) : 0.f;
                const int p1 = 63 - i, pp1 = 63 - jj;
                const float v1 = jj > i ? gcs[192 + p1] * acc[j] * __expf(gcs[64 + p1] - gcs[64 + pp1]) : 0.f;
                Lm[i * 64 + jj] = v0; Lm[4096 + p1 * 64 + pp1] = v1;
            }
        }
        __syncthreads();
        if (w < 6) {
            const int s = w >> 1, dir = w & 1;
            const LAS float* Ld = (const LAS float*)(lds + s * SLOT + 18432) + dir * 4096;
            float xv[64];
#pragma unroll
            for (int i = 0; i < 64; ++i) {
                float s0 = (i == lane) ? 1.f : 0.f, s1 = 0.f, s2 = 0.f, s3 = 0.f;
#pragma unroll
                for (int j4 = 0; j4 < (i + 3) / 4; ++j4) {
                    const f32x4 lv = *(const LAS f32x4*)(Ld + i * 64 + j4 * 4);
                    if (j4 * 4 + 0 < i) s0 -= lv[0] * xv[j4 * 4 + 0];
                    if (j4 * 4 + 1 < i) s1 -= lv[1] * xv[j4 * 4 + 1];
                    if (j4 * 4 + 2 < i) s2 -= lv[2] * xv[j4 * 4 + 2];
                    if (j4 * 4 + 3 < i) s3 -= lv[3] * xv[j4 * 4 + 3];
                }
                xv[i] = (s0 + s1) + (s2 + s3);
            }
            bf16_t* Tg = p.Tbuf + ((((size_t)b * 4 + h) * 36 + c3 * 3 + s) * 2 + dir) * 4096;
#pragma unroll
            for (int i = 0; i < 64; ++i) Tg[i * 64 + lane] = f2bf(xv[i]);
        }
    }
}

constexpr int CH_Q = 0, CH_K = 17408, CH_KT = 34816, CH_VT = 53248, CH_TT = 71680, CH_AT = 80896, CH_WP = 99328, CH_GC = 152576;
template <int MODE>
__device__ NOINL void chain_item(const LAS Params* lp, int l, int item, bool ctx_out, LAS unsigned char* lds) {
    Params p; LP(proj); LP(Tbuf); LP(hbuf); LP(hyproj); LP(ret_decay_logit); LP(gcbuf);
    LAS bf16_t* Qs = (LAS bf16_t*)(lds + CH_Q);
    LAS bf16_t* Ks = (LAS bf16_t*)(lds + CH_K);
    LAS bf16_t* KT = (LAS bf16_t*)(lds + CH_KT);
    LAS bf16_t* VT = (LAS bf16_t*)(lds + CH_VT);
    LAS bf16_t* TT = (LAS bf16_t*)(lds + CH_TT);
    LAS bf16_t* AT = (LAS bf16_t*)(lds + CH_AT);
    LAS float* gcs = (LAS float*)(lds + CH_GC);
    LAS float* bts = gcs + 64;
    const int tid = otid(), w = tid >> 6, lane = tid & 63, fr = lane & 15, fq = lane >> 4;
    LAS bf16_t* ST = (LAS bf16_t*)(lds + CH_WP + w * 6656);
    LAS bf16_t* RP = (LAS bf16_t*)(lds + CH_WP + w * 6656 + 4352);
    int b, h, dir;
    if (MODE == 0) { b = item >> 3; h = (item >> 1) & 3; dir = item & 1; } else { b = item >> 2; h = ((item >> 1) & 1) * 2; dir = item & 1; }
    constexpr int NDK = MODE == 0 ? 8 : 4;
    constexpr int NKS = MODE == 0 ? 4 : 2;
    const int hh = MODE == 0 ? 0 : (w >> 2);
    const int dvrow = MODE == 0 ? 16 * w : 64 * hh + 16 * (w & 3);
    const int kcol = MODE == 0 ? 0 : 64 * hh;
    float lg = 0.f;
    if (MODE == 1) { const float xl = p.ret_decay_logit[l * 8 + dir * 4 + h + hh]; lg = -softplusf(-xl); }
    f32x4 Sacc[NDK];
#pragma unroll
    for (int i = 0; i < NDK; ++i) Sacc[i] = (f32x4){0.f, 0.f, 0.f, 0.f};
    const int tk = tid >> 3, cg8 = tid & 7, pp = dir ? 63 - tk : tk;
    const int ppz = (((pp >> 3) ^ cg8) << 3) | (pp & 7);
    const int vkey = (dvrow >> 4) & 7;
    const int lcol = MODE == 0 ? h * 128 + cg8 * 16 : 2048 + (h + (cg8 >> 2)) * 64 + (cg8 & 3) * 16;
    const int lstep = MODE == 0 ? 512 : 256;
    const int lrow = MODE == 0 ? cg8 * 16 : (cg8 >> 2) * 64 + (cg8 & 3) * 16;
    float lgl = 0.f;
    if (MODE == 1) lgl = -softplusf(-p.ret_decay_logit[l * 8 + dir * 4 + h + (cg8 >> 2)]);
    u32x4 rq[2], rk[2], rv[2], rt; float rg = 0.f;
    auto issue = [&](int n) {
        const int cid = n < 4 ? (dir ? 3 - n : n) : (dir ? 39 - n : n);
        int row0, t0, L; chunk_geom(b, cid, row0, t0, L);
        const bf16_t* src = p.proj + (size_t)(row0 + tk) * 3072 + lcol;
        rq[0] = *(const u32x4*)src; rq[1] = *(const u32x4*)(src + 8);
        rk[0] = *(const u32x4*)(src + lstep); rk[1] = *(const u32x4*)(src + lstep + 8);
        rv[0] = *(const u32x4*)(src + 2 * lstep); rv[1] = *(const u32x4*)(src + 2 * lstep + 8);
        if (MODE == 0) {
            rt = *(const u32x4*)(p.Tbuf + ((((size_t)b * 4 + h) * 36 + cid) * 2 + dir) * 4096 + tid * 8);
            if (tid < 192) rg = p.gcbuf[((((size_t)b * 4 + h) * 36 + cid) * 2 + dir) * 192 + tid];
        }
    };
    issue(0);
    for (int n = 0; n < 36; ++n) {
        const int cid = n < 4 ? (dir ? 3 - n : n) : (dir ? 39 - n : n);
        int row0, t0, L; chunk_geom(b, cid, row0, t0, L);
        __syncthreads();
        u32x4 kk0 = rk[0], kk1 = rk[1];
        *(LAS u32x4*)(Qs + pp * 136 + lrow) = rq[0]; *(LAS u32x4*)(Qs + pp * 136 + lrow + 8) = rq[1];
        *(LAS u32x4*)(Ks + pp * 136 + lrow) = kk0; *(LAS u32x4*)(Ks + pp * 136 + lrow + 8) = kk1;
        {
            const unsigned vv[8] = {rv[0].x, rv[0].y, rv[0].z, rv[0].w, rv[1].x, rv[1].y, rv[1].z, rv[1].w};
#pragma unroll
            for (int e = 0; e < 8; ++e) { VT[(lrow + 2 * e) * 72 + ppz] = (bf16_t)(vv[e] & 0xFFFFu); VT[(lrow + 2 * e + 1) * 72 + ppz] = (bf16_t)(vv[e] >> 16); }
        }
        if (MODE == 0) {
            *(LAS u32x4*)(TT + (tid >> 3) * 72 + (tid & 7) * 8) = rt;
            if (tid < 192) gcs[tid] = rg;
        } else {
            const float ksc = __expf((float)(63 - pp) * lgl);
            float kf[16]; unpack8(kk0, kf); unpack8(kk1, kf + 8);
#pragma unroll
            for (int e = 0; e < 16; ++e) KT[(lrow + e) * 72 + ppz] = f2bf(kf[e] * ksc);
        }
        __syncthreads();
        if (n + 1 < 36) issue(n + 1);
        if (MODE == 0) {
            const float sc = __expf(gcs[63] - gcs[pp]);
            {
                float kf[16]; unpack8(kk0, kf); unpack8(kk1, kf + 8);
#pragma unroll
                for (int e = 0; e < 16; ++e) KT[(lrow + e) * 72 + ppz] = f2bf(kf[e] * sc);
            }
            const int ct = w >> 1;
#pragma unroll
            for (int jj = 0; jj < 2; ++jj) {
                const int st = 2 * (w & 1) + jj; f32x4 acc = {0.f, 0.f, 0.f, 0.f};
#pragma unroll
                for (int ks = 0; ks < 4; ++ks) {
                    const bf16x8 A = *(const LAS bf16x8*)(Qs + (16 * ct + fr) * 136 + ks * 32 + fq * 8), B = *(const LAS bf16x8*)(Ks + (16 * st + fr) * 136 + ks * 32 + fq * 8);
                    acc = MFMA16(A, B, acc);
                }
                const int s = 16 * st + fr; const float gs = gcs[s];
#pragma unroll
                for (int j = 0; j < 4; ++j) { const int c = 16 * ct + 4 * fq + j; AT[c * 72 + s] = f2bf(s <= c ? acc[j] * __expf(gcs[c] - gs) : 0.f); }
            }
        } else {
            const int ct = w & 3;
#pragma unroll
            for (int st = 0; st < 4; ++st) {
                f32x4 acc = {0.f, 0.f, 0.f, 0.f};
#pragma unroll
                for (int ks = 0; ks < 2; ++ks) {
                    const bf16x8 A = *(const LAS bf16x8*)(Qs + (16 * ct + fr) * 136 + kcol + ks * 32 + fq * 8), B = *(const LAS bf16x8*)(Ks + (16 * st + fr) * 136 + kcol + ks * 32 + fq * 8);
                    acc = MFMA16(A, B, acc);
                }
                const int s = 16 * st + fr;
#pragma unroll
                for (int j = 0; j < 4; ++j) { const int c = 16 * ct + 4 * fq + j; AT[hh * 4608 + c * 72 + s] = f2bf(s <= c ? acc[j] * __expf((float)(c - s) * lg) : 0.f); }
            }
        }
        __syncthreads();
#pragma unroll
        for (int dk = 0; dk < NDK; ++dk) { u32x2 pk; pk.x = pk2(Sacc[dk][0], Sacc[dk][1]); pk.y = pk2(Sacc[dk][2], Sacc[dk][3]); *(LAS u32x2*)(ST + fr * 136 + 16 * dk + 4 * fq) = pk; }
        WAVE_SYNC();
        f32x4 qs[4], ksm[4];
#pragma unroll
        for (int ct = 0; ct < 4; ++ct) { qs[ct] = (f32x4){0.f, 0.f, 0.f, 0.f}; ksm[ct] = (f32x4){0.f, 0.f, 0.f, 0.f}; }
#pragma unroll
        for (int ks = 0; ks < NKS; ++ks) {
            const bf16x8 Bf = *(const LAS bf16x8*)(ST + fr * 136 + ks * 32 + fq * 8);
#pragma unroll
            for (int ct = 0; ct < 4; ++ct) {
                const bf16x8 Aq = *(const LAS bf16x8*)(Qs + (16 * ct + fr) * 136 + kcol + ks * 32 + fq * 8);
                qs[ct] = MFMA16(Aq, Bf, qs[ct]);
                if (MODE == 0) { const bf16x8 Ak = *(const LAS bf16x8*)(Ks + (16 * ct + fr) * 136 + ks * 32 + fq * 8); ksm[ct] = MFMA16(Ak, Bf, ksm[ct]); }
            }
        }
        float eg[4][4];
#pragma unroll
        for (int ct = 0; ct < 4; ++ct)
#pragma unroll
            for (int j = 0; j < 4; ++j) { const int c = 16 * ct + 4 * fq + j; eg[ct][j] = MODE == 0 ? gcs[128 + c] : __expf((float)(c + 1) * lg); }
        bf16x8 Bv[2];
        if (MODE == 0) {
#pragma unroll
            for (int ct = 0; ct < 4; ++ct) {
                const u32x2 vv = *(const LAS u32x2*)(VT + (dvrow + fr) * 72 + (((2 * ct + (fq >> 1)) ^ vkey) << 3) + 4 * (fq & 1));
                const float v4[4] = {bflo(vv.x), bfhi(vv.x), bflo(vv.y), bfhi(vv.y)};
                float r[4];
#pragma unroll
                for (int j = 0; j < 4; ++j) r[j] = bts[16 * ct + 4 * fq + j] * (v4[j] - eg[ct][j] * ksm[ct][j]);
                u32x2 pk; pk.x = pk2(r[0], r[1]); pk.y = pk2(r[2], r[3]);
                *(LAS u32x2*)(RP + fr * 72 + 16 * ct + 4 * fq) = pk;
            }
            WAVE_SYNC();
            bf16x8 Br[2];
            Br[0] = *(const LAS bf16x8*)(RP + fr * 72 + fq * 8); Br[1] = *(const LAS bf16x8*)(RP + fr * 72 + 32 + fq * 8);
            f32x4 vn[4];
#pragma unroll
            for (int ct = 0; ct < 4; ++ct) {
                vn[ct] = (f32x4){0.f, 0.f, 0.f, 0.f};
#pragma unroll
                for (int ks = 0; ks < 2; ++ks) { const bf16x8 A = *(const LAS bf16x8*)(TT + (16 * ct + fr) * 72 + ks * 32 + fq * 8); vn[ct] = MFMA16(A, Br[ks], vn[ct]); }
            }
            WAVE_SYNC();
#pragma unroll
            for (int ct = 0; ct < 4; ++ct) { u32x2 pk; pk.x = pk2(vn[ct][0], vn[ct][1]); pk.y = pk2(vn[ct][2], vn[ct][3]); *(LAS u32x2*)(RP + fr * 72 + 16 * ct + 4 * fq) = pk; }
            WAVE_SYNC();
            Bv[0] = *(const LAS bf16x8*)(RP + fr * 72 + fq * 8); Bv[1] = *(const LAS bf16x8*)(RP + fr * 72 + 32 + fq * 8);
        } else {
            Bv[0] = *(const LAS bf16x8*)(VT + (dvrow + fr) * 72 + ((fq ^ vkey) << 3)); Bv[1] = *(const LAS bf16x8*)(VT + (dvrow + fr) * 72 + (((4 + fq) ^ vkey) << 3));
        }
        {
            typedef __attribute__((address_space(1))) bf16_t gbf16;
            bf16_t* ob; int ldo;
            if (MODE == 0) { if (dir == 0) { ob = p.hbuf + 256 + h * 128 + 16 * w; ldo = 1024; } else { ob = p.hyproj + h * 128 + 16 * w; ldo = 768; } }
            else { if (dir == 0) { ob = p.hbuf + 768 + (h + hh) * 64 + 16 * (w & 3); ldo = 1024; } else { ob = p.hyproj + 512 + (h + hh) * 64 + 16 * (w & 3); ldo = 768; } }
#pragma unroll
            for (int ct = 0; ct < 4; ++ct) {
                f32x4 acc = {0.f, 0.f, 0.f, 0.f};
#pragma unroll
                for (int ks = 0; ks < 2; ++ks) { const bf16x8 A = *(const LAS bf16x8*)(AT + hh * 4608 + (16 * ct + fr) * 72 + ks * 32 + fq * 8); acc = MFMA16(A, Bv[ks], acc); }
                gbf16* og = (gbf16*)ob + (size_t)row0 * ldo + fr;
#pragma unroll
                for (int j = 0; j < 4; ++j) { const int c = 16 * ct + 4 * fq + j, tok = dir ? 63 - c : c; og[tok * ldo] = f2bf(eg[ct][j] * qs[ct][j] + acc[j]); }
            }
        }
        {
            const float gl = MODE == 0 ? gcs[128 + 63] : __expf(64.f * lg);
#pragma unroll
            for (int dk = 0; dk < NDK; ++dk) {
                Sacc[dk] = Sacc[dk] * gl;
#pragma unroll
                for (int ks = 0; ks < 2; ++ks) { const bf16x8 A = *(const LAS bf16x8*)(KT + (kcol + 16 * dk + fr) * 72 + (((ks * 4 + fq) ^ (((kcol >> 4) + dk) & 7)) << 3)); Sacc[dk] = MFMA16(A, Bv[ks], Sacc[dk]); }
            }
        }
    }
}

template <int L>
__device__ NOINL void hyena_item(const LAS Params* lp, int l, int c, LAS unsigned char* lds) {
    Params p; LP(Fl); LP(Fc); LP(hyT); LP(hyTc); LP(hy_bias); LP(hyO); LP(hyOc);
    constexpr int NTB = L / 128, NS = L / 32, FSB = (2 * L + 16) * 2, USB = (L + 8) * 2, UOFF = 8 * FSB;
    const int tid = otid(), w = tid >> 6, lane = tid & 63, fr = lane & 15, fq = lane >> 4;
    const bf16_t* Fg = (L == SEQ ? p.Fl : p.Fc);
    const bf16_t* hT = (L == SEQ ? p.hyT : p.hyTc);
    bf16_t* hO = (L == SEQ ? p.hyO : p.hyOc);
    const float bias0 = p.hy_bias[l * 512 + c], bias1 = p.hy_bias[l * 512 + 256 + c];
    __syncthreads();
    for (int i = tid; i < 16 * L / 8; i += 512) { const int bb = i / (L / 8), s8 = (i % (L / 8)) * 8; *(LAS u32x4*)(lds + UOFF + bb * USB + s8 * 2) = *(const u32x4*)(hT + ((size_t)c * NB + bb) * L + s8); }
    const int e0 = 8 * fq - fr + L - 16 * (w * NTB + NTB - 1);
    const int abase = (e0 & 7) * FSB + 16 * (e0 >> 3);
    for (int order = 0; order < 2; ++order) {
        const bf16_t* Fr = Fg + ((size_t)order * 256 + c) * (2 * L);
        for (int i = tid; i < 2 * L + 8; i += 512) {
            const bf16_t v = i < 2 * L ? Fr[i] : (bf16_t)0;
#pragma unroll
            for (int r = 0; r < 8; ++r) if (i - r >= 0) *(LAS bf16_t*)(lds + r * FSB + (i - r) * 2) = v;
        }
        if (tid < 64) { const int r = tid >> 3, k = tid & 7; if (k < r) *(LAS bf16_t*)(lds + r * FSB + (2 * L + 8 - 1 - k) * 2) = 0; }
        __syncthreads();
        f32x4 acc[NTB];
#pragma unroll
        for (int a = 0; a < NTB; ++a) acc[a] = (f32x4){0.f, 0.f, 0.f, 0.f};
#pragma unroll 1
        for (int sb = 0; sb < NS; sb += 4) {
            bf16x8 Bf[4];
#pragma unroll
            for (int u = 0; u < 4; ++u) Bf[u] = *(const LAS bf16x8*)(lds + UOFF + fr * USB + (sb + u) * 64 + fq * 16);
            bf16x8 Af[NTB + 6];
#pragma unroll
            for (int k = 0; k < NTB + 6; ++k) Af[k] = *(const LAS bf16x8*)(lds + abase + sb * 64 + k * 32);
#pragma unroll
            for (int a = 0; a < NTB; ++a)
#pragma unroll
                for (int u = 0; u < 4; ++u) acc[a] = MFMA16(Af[NTB - 1 - a + 2 * u], Bf[u], acc[a]);
        }
        __syncthreads();
        const bf16_t* gT = hT + ((size_t)((order + 1) * 256 + c) * NB + fr) * L;
#pragma unroll
        for (int a = 0; a < NTB; ++a) {
            const int t = 16 * (w * NTB + a) + 4 * fq;
            const u32x2 gv = *(const u32x2*)(gT + t);
            LAS u32x2* up = (LAS u32x2*)(lds + UOFF + fr * USB + t * 2);
            const u32x2 uv = *up;
            const float bias = order == 0 ? bias0 : bias1;
            const float r0 = bflo(gv.x) * (acc[a][0] + bflo(uv.x) * bias), r1 = bfhi(gv.x) * (acc[a][1] + bfhi(uv.x) * bias);
            const float r2 = bflo(gv.y) * (acc[a][2] + bflo(uv.y) * bias), r3 = bfhi(gv.y) * (acc[a][3] + bfhi(uv.y) * bias);
            u32x2 pk; pk.x = pk2(r0, r1); pk.y = pk2(r2, r3);
            if (order == 0) *up = pk;
            else *(u32x2*)(hO + ((size_t)c * NB + fr) * L + t) = pk;
        }
        __syncthreads();
    }
}

__device__ NOINL void wt_in_item(const LAS Params* lp, int l, int item, LAS unsigned char* lds) {
    Params p; LP(w_in); LP(Wt_in);
    const int tid = otid(), k0 = (item >> 4) * 64, n0 = (item & 15) * 256;
    const float* W = p.w_in + (size_t)l * DM * INW;
    LAS bf16_t* ts = (LAS bf16_t*)lds;
    __syncthreads();
    f32x4 v[2][4];
#pragma unroll
    for (int pass = 0; pass < 2; ++pass)
#pragma unroll
        for (int q = 0; q < 4; ++q) {
            const int kk = pass * 32 + (tid >> 4), nn = q * 64 + (tid & 15) * 4;
            v[pass][q] = (n0 + nn < INW) ? *(const f32x4*)(W + (size_t)(k0 + kk) * INW + n0 + nn) : (f32x4){0.f, 0.f, 0.f, 0.f};
        }
#pragma unroll
    for (int pass = 0; pass < 2; ++pass)
#pragma unroll
        for (int q = 0; q < 4; ++q) {
            const int kk = pass * 32 + (tid >> 4), nn = q * 64 + (tid & 15) * 4;
            ts[(nn + 0) * 72 + kk] = f2bf(v[pass][q][0]); ts[(nn + 1) * 72 + kk] = f2bf(v[pass][q][1]); ts[(nn + 2) * 72 + kk] = f2bf(v[pass][q][2]); ts[(nn + 3) * 72 + kk] = f2bf(v[pass][q][3]);
        }
    __syncthreads();
    const int nn = tid >> 1, k32 = (tid & 1) * 32;
    if (n0 + nn < INW) {
        bf16_t* d = p.Wt_in + (size_t)wt_map(1, n0 + nn) * DM + k0 + k32;
#pragma unroll
        for (int q = 0; q < 4; ++q) *(u32x4*)(d + q * 8) = *(const LAS u32x4*)(ts + nn * 72 + k32 + q * 8);
    }
}

__device__ __forceinline__ void mixer_phase(const LAS Params* lp, int l, int rp, LAS unsigned char* lds, const XcdBarrier& xb) {
    const bool ctxo = (l == 0);
    const int nq = 64 + 256 + (ctxo ? 256 + 256 : 0);
    unsigned* ctr = uni(lp->ctl) + 3584 + 64 * l + 16 * rp;
    LAS int* slot = (LAS int*)(lds + PARAM_OFF + 512);
#ifdef SERIAL_MIX
    for (int r = 0; r < SERIAL_MIX; ++r) { for (int it = blockIdx.x; it < 128; it += gridDim.x) chain_item<0>(lp, l, it, ctxo, lds); xcd_barrier(xb); }
#else
    for (int it = blockIdx.x; it < 128; it += gridDim.x) chain_item<0>(lp, l, it, ctxo, lds);
#endif
#ifndef NOQ
    for (;;) {
        __syncthreads();
        if (threadIdx.x == 0) *slot = (int)atomicAdd(ctr, 1u);
        __syncthreads();
        const int it = *slot;
        if (it >= nq) break;
        if (it < 64) chain_item<1>(lp, l, it, ctxo, lds);
        else if (it < 320) hyena_item<SEQ>(lp, l, it - 64, lds);
        else if (it < 576) hyena_item<CTXL>(lp, l, it - 320, lds);
        else wt_in_item(lp, 1, it - 576, lds);
    }
#endif
}

__device__ NOINL void combine_phase(const LAS Params* lp, int l, LAS unsigned char* lds) {
    Params p; LP(gdn_norm_g); LP(hyO); LP(hyOc); LP(hbuf); LP(hyproj); LP(proj);
    LAS bf16_t* ts = (LAS bf16_t*)lds;
    const int tid = otid(), w = tid >> 6, lane = tid & 63;
    const int ntt = (l == 0 ? NTOK : NLAT) / 64;
    float ng8[8];
#pragma unroll
    for (int e = 0; e < 8; ++e) ng8[e] = p.gdn_norm_g[l * 128 + (lane & 15) * 8 + e];
    for (int tt = blockIdx.x; tt < ntt; tt += gridDim.x) {
        const int row0 = tt * 64; const bool il = row0 < NLAT; const int L = il ? SEQ : CTXL;
        const int b = il ? row0 / SEQ : (row0 - NLAT) / CTXL, t0 = il ? row0 % SEQ : (row0 - NLAT) % CTXL;
        const bf16_t* hT = il ? p.hyO : p.hyOc;
        __syncthreads();
        {
            const int ch = tid >> 1, hf = tid & 1;
            const bf16_t* src = hT + ((size_t)ch * NB + b) * L + t0 + hf * 32;
#pragma unroll
            for (int q = 0; q < 4; ++q) {
                const u32x4 v = *(const u32x4*)(src + q * 8);
                const unsigned uu[4] = {v.x, v.y, v.z, v.w};
#pragma unroll
                for (int e = 0; e < 4; ++e) { const int tk = hf * 32 + q * 8 + 2 * e; ts[tk * 264 + ch] = (bf16_t)(uu[e] & 0xFFFFu); ts[(tk + 1) * 264 + ch] = (bf16_t)(uu[e] >> 16); }
            }
        }
        __syncthreads();
        {
            const int tk = tid >> 3, seg = (tid & 7) * 32;
#pragma unroll
            for (int q = 0; q < 4; ++q) *(u32x4*)(p.hbuf + (size_t)(row0 + tk) * DM + seg + q * 8) = *(const LAS u32x4*)(ts + tk * 264 + seg + q * 8);
        }
#pragma unroll
        for (int i = 0; i < 8; ++i) {
            const size_t row = (size_t)(row0 + 8 * w + i);
            float of[8], ob[8], zz[8];
            unpack8(*(const u32x4*)(p.hbuf + row * DM + 256 + lane * 8), of); unpack8(*(const u32x4*)(p.hyproj + row * 768 + lane * 8), ob); unpack8(*(const u32x4*)(p.proj + row * 3072 + 1536 + lane * 8), zz);
            float ss = 0.f;
#pragma unroll
            for (int e = 0; e < 8; ++e) { of[e] += ob[e]; ss += of[e] * of[e]; }
            ss += __shfl_xor(ss, 1); ss += __shfl_xor(ss, 2); ss += __shfl_xor(ss, 4); ss += __shfl_xor(ss, 8);
            const float inv = rsqrtf(ss * (1.f / 128.f) + 1e-6f);
            float o[8];
#pragma unroll
            for (int e = 0; e < 8; ++e) o[e] = of[e] * inv * ng8[e] * siluf(zz[e]);
            u32x4 pk; pk.x = pk2(o[0], o[1]); pk.y = pk2(o[2], o[3]); pk.z = pk2(o[4], o[5]); pk.w = pk2(o[6], o[7]);
            *(u32x4*)(p.hbuf + row * DM + 256 + lane * 8) = pk;
        }
#pragma unroll
        for (int i = 0; i < 4; ++i) {
            const size_t row = (size_t)(row0 + 8 * w + 2 * i + (lane >> 5)); const int l32 = lane & 31;
            float of[8], ob[8], gg[8];
            unpack8(*(const u32x4*)(p.hbuf + row * DM + 768 + l32 * 8), of); unpack8(*(const u32x4*)(p.hyproj + row * 768 + 512 + l32 * 8), ob); unpack8(*(const u32x4*)(p.proj + row * 3072 + 2816 + l32 * 8), gg);
            float s1 = 0.f;
#pragma unroll
            for (int e = 0; e < 8; ++e) { of[e] += ob[e]; s1 += of[e]; }
            s1 += __shfl_xor(s1, 1); s1 += __shfl_xor(s1, 2); s1 += __shfl_xor(s1, 4);
            const float mu = s1 * (1.f / 64.f); float s2 = 0.f;
#pragma unroll
            for (int e = 0; e < 8; ++e) { of[e] -= mu; s2 += of[e] * of[e]; }
            s2 += __shfl_xor(s2, 1); s2 += __shfl_xor(s2, 2); s2 += __shfl_xor(s2, 4);
            const float inv = rsqrtf(s2 * (1.f / 64.f) + 1e-6f);
            float o[8];
#pragma unroll
            for (int e = 0; e < 8; ++e) o[e] = of[e] * inv * siluf(gg[e]);
            u32x4 pk; pk.x = pk2(o[0], o[1]); pk.y = pk2(o[2], o[3]); pk.z = pk2(o[4], o[5]); pk.w = pk2(o[6], o[7]);
            *(u32x4*)(p.hbuf + row * DM + 768 + l32 * 8) = pk;
        }
    }
}

__device__ NOINL void gemm_in_phase(const LAS Params* lp, LAS unsigned char* lds) {
    Params p; LP(hbuf); LP(Wt_in); LP(hyproj); LP(proj); LP(ab); LP(halo);
    pg8::StaticOrder S; S.init(NTOK, 4096, DM, gridDim.x, blockIdx.x); pg8::EpiProj E{p.hyproj, p.proj, p.ab, p.halo};
    pg8::gemm_phase(lds, pg8::Gemm{p.hbuf, p.Wt_in, NTOK, 4096, DM}, S, E);
}
__device__ NOINL void gemm_out_phase(const LAS Params* lp, int l, LAS unsigned char* lds) {
    Params p; LP(hbuf); LP(Wt_out); LP(x); LP(ctx); LP(out); LP(ctx_x); LP(modbuf); LP(hyT);
    const bool tail = (l == 0) && gridDim.x == 256;
    const int Mf = (l == 0 && !tail) ? NTOK : NLAT;
    pg8::StaticOrder S; S.init(Mf, DM, DM, gridDim.x, blockIdx.x, tail ? 1 : 0);
    pg8::EpiRes E{l == 0 ? p.x : p.out, l == 0 ? p.ctx : p.ctx_x, p.out, p.ctx_x, p.modbuf + (size_t)l * 17 * 6144 + 2 * 1024, (float*)p.hyT};
    pg8::gemm_phase(lds, pg8::Gemm{p.hbuf, p.Wt_out, Mf, DM, DM}, S, E);
}
__device__ NOINL void gemm_f1_phase(const LAS Params* lp, int l, LAS unsigned char* lds) {
    Params p; LP(hbuf); LP(Wt_f1); LP(proj);
    const int Mf = l == 0 ? NTOK : NLAT;
    pg8::StaticOrder S; S.init(Mf, 2 * FFH, DM, gridDim.x, blockIdx.x); pg8::EpiSwiglu E{p.proj};
    pg8::gemm_phase(lds, pg8::Gemm{p.hbuf, p.Wt_f1, Mf, 2 * FFH, DM}, S, E);
}
__device__ NOINL void gemm_f2_phase(const LAS Params* lp, int l, LAS unsigned char* lds) {
    Params p; LP(proj); LP(Wt_f2); LP(out); LP(ctx_x); LP(modbuf); LP(hyT);
    const bool tail = (l == 0) && gridDim.x == 256;
    const int Mf = (l == 0 && !tail) ? NTOK : NLAT;
    pg8::StaticOrder S; S.init(Mf, DM, FFH, gridDim.x, blockIdx.x, tail ? 1 : 0);
    pg8::EpiRes E{p.out, p.ctx_x, p.out, p.ctx_x, p.modbuf + (size_t)l * 17 * 6144 + 5 * 1024, (float*)p.hyT};
    pg8::gemm_phase(lds, pg8::Gemm{p.proj, p.Wt_f2, Mf, DM, FFH}, S, E);
}

__global__ void __launch_bounds__(512) mega_fwd(Params p) {
    extern __shared__ __attribute__((aligned(16))) unsigned char smem_raw[];
    LAS unsigned char* lds = (LAS unsigned char*)smem_raw;
    int ph = 0;
#if MK_MULTI
#define SEAM()
#define RUN (ph >= (int)p.ph_lo && ph < (int)p.ph_hi)
#else
    cg::grid_group grid = cg::this_grid();
    volatile LAS unsigned* xst = (volatile LAS unsigned*)(lds + PARAM_OFF + 520);
    if (threadIdx.x == 0) { xst[0] = 0u; xst[1] = 0u; }
    __syncthreads();
    const XcdBarrier xb = xcd_barrier_post(p.ctl, xst);
#define SEAM() do { if (p.ph_lo == 0x7fffffffLL) grid.sync(); else xcd_barrier(xb); } while (0)
#define RUN true
#endif
    LAS Params* lp = (LAS Params*)(lds + PARAM_OFF);
    if (threadIdx.x == 0) {
#pragma unroll
        for (int i = 0; i < (int)(sizeof(Params) / 8); ++i) ((LAS unsigned long long*)lp)[i] = ((const unsigned long long*)&p)[i];
    }
    __syncthreads();
    for (int rp = 0; rp < ((DUP & 1) ? 2 : 1); ++rp) { if (rp) xcd_barrier(xb); if (RUN && (PHM & 1)) { prep_mod(lp, lds); prep_weights(lp, 0, lds); prep_filters(lp, 0, true, lds); prep_rope(lp); } }
    ++ph; SEAM();
    const bool tailk = gridDim.x == 256;
#pragma unroll 1
    for (int l = 0; l < 2; ++l) {
        const float* xl = l == 0 ? p.x : p.out; const float* xc = l == 0 ? p.ctx : p.ctx_x;
        const float* mod = p.modbuf + (size_t)l * 17 * 6144;
        const int Mf = l == 0 ? NTOK : NLAT;
        if (DUP & 2) { norm_mod_phase(xl, xc, NTOK, p.norm1_g + l * DM, mod, 0, p.hbuf); xcd_barrier(xb); }
        if (RUN && (PHM & 2)) {
            if (l == 1 && tailk) norm_mod_phase(xl, xc, NTOK, p.norm1_g + l * DM, mod, 0, p.hbuf, (const float*)p.hyT, p.modbuf + 16 * 6144 + 5 * 1024, nullptr);
            else norm_mod_phase(xl, xc, NTOK, p.norm1_g + l * DM, mod, 0, p.hbuf);
            if (l == 1) { prep_weights(lp, 1, lds, 256); prep_filters(lp, 1, false, lds); }
        }
        ++ph; SEAM();
        for (int rp = 0; rp < ((DUP & 4) ? 2 : 1); ++rp) { if (rp) xcd_barrier(xb); if (RUN && (PHM & 4)) gemm_in_phase(lp, lds); }
        ++ph; SEAM();
        for (int rp = 0; rp < ((DUP & 8) ? 2 : 1); ++rp) { if (rp) xcd_barrier(xb); if (RUN && (PHM & 8)) h1_phase(lp, l, l == 0, lds); }
        if (RUN) qkvn_phase(lp, l, lds);
        ++ph; SEAM();
        for (int rp = 0; rp < ((DUP & 16) ? 2 : 1); ++rp) { if (rp) xcd_barrier(xb); if (RUN && (PHM & 16)) g1_phase(lp, l, lds); }
        ++ph; SEAM();
        for (int rp = 0; rp < ((DUP & 32) ? 2 : 1); ++rp) { if (rp) xcd_barrier(xb); if (RUN && (PHM & 32)) mixer_phase(lp, l, rp, lds, xb); }
        ++ph; SEAM();
        if (RUN && (PHM & 64)) combine_phase(lp, l, lds);
        ++ph; SEAM();
        if (RUN && (PHM & 128)) gemm_out_phase(lp, l, lds);
        ++ph; SEAM();
        if (RUN && (PHM & 256)) {
            if (l == 0 && tailk) norm_mod_phase(p.out, p.ctx, Mf, p.norm2_g + l * DM, mod, 3, p.hbuf, (const float*)p.hyT, mod + 16 * 6144 + 2 * 1024, p.ctx_x);
            else norm_mod_phase(p.out, p.ctx_x, Mf, p.norm2_g + l * DM, mod, 3, p.hbuf);
        }
        ++ph; SEAM();
        for (int rp = 0; rp < ((DUP & 512) ? 2 : 1); ++rp) { if (rp) xcd_barrier(xb); if (RUN && (PHM & 512)) gemm_f1_phase(lp, l, lds); }
        ++ph; SEAM();
        if (RUN && (PHM & 1024)) gemm_f2_phase(lp, l, lds);
        ++ph; SEAM();
    }
    if (DUP & 64) { for (int i = 0; i < 20; ++i) xcd_barrier(xb); }
    if (RUN && (PHM & 2048)) final_norm_phase(p.out, p.final_norm_g);
}
constexpr int N_PHASES = 1 + 2 * 10 + 1;

extern "C" void kernel_launch(void* const* d_in, const int* in_sizes, int n_in, void* d_out, int out_size, void* d_ws, size_t ws_size, hipStream_t stream) {
    static int grid = 0;
    if (grid == 0) {
        int dev = 0, cus = 0, per_cu = 0;
        hipGetDevice(&dev);
        hipDeviceGetAttribute(&cus, hipDeviceAttributeMultiprocessorCount, dev);
        if (hipFuncSetAttribute((const void*)mega_fwd, hipFuncAttributeMaxDynamicSharedMemorySize, LDS_BYTES) != hipSuccess) { fprintf(stderr, "kernel_launch: hipFuncSetAttribute failed\n"); grid = -1; return; }
        if (hipOccupancyMaxActiveBlocksPerMultiprocessor(&per_cu, (const void*)mega_fwd, 512, LDS_BYTES) != hipSuccess || per_cu < 1) { fprintf(stderr, "kernel_launch: occupancy query gave %d\n", per_cu); per_cu = 1; }
        (void)hipGetLastError();
        grid = cus * per_cu;
    }
    if (grid < 0) return;
    Params p{};
    const float** pin = (const float**)&p.x;
    for (int i = 0; i < 28; ++i) pin[i] = (const float*)d_in[i];
    p.out = (float*)d_out;
    unsigned char* ws = (unsigned char*)d_ws; size_t off = 0;
    auto take = [&](size_t bytes) { unsigned char* r = ws + off; off += (bytes + 255) & ~(size_t)255; return r; };
    p.modbuf = (float*)take((size_t)2 * 17 * 6144 * 4);
    p.Fl = (bf16_t*)take((size_t)2 * 256 * 4096 * 2);
    p.Fc = (bf16_t*)take((size_t)2 * 256 * 512 * 2);
    p.Wt_in = (bf16_t*)take((size_t)4096 * DM * 2);
    p.Wt_out = (bf16_t*)take((size_t)DM * DM * 2);
    p.Wt_f1 = (bf16_t*)take((size_t)2 * FFH * DM * 2);
    p.Wt_f2 = (bf16_t*)take((size_t)DM * FFH * 2);
    p.ctx_x = (float*)take((size_t)NCTX * DM * 4);
    p.hbuf = (bf16_t*)take((size_t)NTOK * DM * 2);
    p.ab = (float*)take((size_t)NTOK * 16 * 4);
    p.hyproj = (bf16_t*)take((size_t)NTOK * 768 * 2);
    p.proj = (bf16_t*)take((size_t)NTOK * 3072 * 2);
    p.hyT = (bf16_t*)take((size_t)768 * NB * SEQ * 2);
    p.hyTc = (bf16_t*)take((size_t)768 * NB * CTXL * 2);
    p.Tbuf = (bf16_t*)take((size_t)4608 * 4096 * 2);
    p.hyO = (bf16_t*)take((size_t)256 * NB * SEQ * 2);
    p.hyOc = (bf16_t*)take((size_t)256 * NB * CTXL * 2);
    p.halo = (bf16_t*)take((size_t)576 * 2 * 1536 * 2);
    p.ropeT = (float*)take((size_t)SEQ * 32 * 2 * 4);
    p.ctl = (unsigned*)take(16384);
    p.gcbuf = (float*)take((size_t)4608 * 192 * 4);
    if (off > ws_size) { fprintf(stderr, "kernel_launch: workspace too small: need %zu, have %zu\n", off, ws_size); return; }
    if (hipMemsetAsync(p.ctl, 0, 16384, stream) != hipSuccess) { fprintf(stderr, "kernel_launch: memset failed\n"); return; }
#if MK_MULTI
    for (int ph = 0; ph < N_PHASES; ++ph) { p.ph_lo = ph; p.ph_hi = ph + 1; hipLaunchKernelGGL(mega_fwd, dim3(grid), dim3(512), LDS_BYTES, stream, p); }
#else
    p.ph_lo = 0; p.ph_hi = N_PHASES;
    void* args[] = {&p};
    hipError_t e = hipLaunchCooperativeKernel((const void*)mega_fwd, dim3(grid), dim3(512), args, LDS_BYTES, stream);
    if (e != hipSuccess) fprintf(stderr, "cooperative launch failed: %s (grid %d)\n", hipGetErrorString(e), grid);
#endif
}
```

```cpp
#include <hip/hip_runtime.h>
#include <hip/hip_cooperative_groups.h>
#include <cstdio>
#include <cstdint>
namespace cg = cooperative_groups;

#ifndef MK_MULTI
#define MK_MULTI 0
#endif

#ifndef PHM
#define PHM 0xFFFF
#endif
#ifndef DUP
#define DUP 0
#endif
#define LAS __attribute__((address_space(3)))
typedef unsigned short bf16_t;
typedef short bf16x8 __attribute__((ext_vector_type(8)));
typedef float f32x4 __attribute__((ext_vector_type(4)));
typedef unsigned u32x4 __attribute__((ext_vector_type(4)));
typedef unsigned u32x2 __attribute__((ext_vector_type(2)));

constexpr int DM = 1024, NB = 16, SEQ = 2048, CTXL = 256, NLAT = NB * SEQ, NCTX = NB * CTXL, NTOK = NLAT + NCTX;
constexpr int INW = 3856, FFH = 2816;
constexpr int LDS_BYTES = 156 * 1024;
constexpr int PARAM_OFF = 155 * 1024;

struct Params {
    const float *x, *c, *ctx, *c_ctx, *mod_w, *mod_b, *norm1_g, *w_in, *hy_conv_w, *hy_conv_b, *hy_f_w1, *hy_f_b1, *hy_f_freq1, *hy_f_w2, *hy_f_b2, *hy_f_freq2,
        *hy_f_w3, *hy_bias, *gdn_conv_w, *gdn_a_log, *gdn_dt_bias, *gdn_norm_g, *ret_decay_logit, *w_out, *norm2_g, *ffn_w_in, *ffn_w_out, *final_norm_g;
    float* out;
    float* modbuf;
    bf16_t* Fl;
    bf16_t* Fc;
    bf16_t *Wt_in, *Wt_out, *Wt_f1, *Wt_f2;
    float* ctx_x;
    bf16_t* hbuf;
    float* ab;
    bf16_t* hyproj;
    bf16_t* proj;
    bf16_t* hyT;
    bf16_t* hyTc;
    bf16_t* Tbuf;
    bf16_t* hyO;
    bf16_t* hyOc;
    bf16_t* halo;
    float* ropeT;
    unsigned* ctl;
    float* gcbuf;
    long long ph_lo, ph_hi;
};

template <class T> __device__ __forceinline__ T* uni(T* ptr) { const unsigned long long v = (unsigned long long)ptr; const unsigned lo = __builtin_amdgcn_readfirstlane((unsigned)v), hi = __builtin_amdgcn_readfirstlane((unsigned)(v >> 32));
    return (T*)((__attribute__((address_space(1))) T*)(((unsigned long long)hi << 32) | lo)); }
#define LP(f) p.f = uni(lp->f)
__device__ __forceinline__ int otid() { int t = threadIdx.x; asm volatile("" : "+v"(t)); return t; }
#define NOINL __forceinline__
typedef __bf16 bf16v2_t __attribute__((ext_vector_type(2)));
typedef float f32v2_t __attribute__((ext_vector_type(2)));
__device__ __forceinline__ unsigned pk2(float lo, float hi) { const f32v2_t f = {lo, hi}; const bf16v2_t b = __builtin_convertvector(f, bf16v2_t); return __builtin_bit_cast(unsigned, b); }
__device__ __forceinline__ bf16_t f2bf(float f) { return (bf16_t)(pk2(f, f) & 0xFFFFu); }
__device__ __forceinline__ float bf2f(unsigned b) { return __uint_as_float(b << 16); }
__device__ __forceinline__ float bflo(unsigned u) { return __uint_as_float(u << 16); }
__device__ __forceinline__ float bfhi(unsigned u) { return __uint_as_float(u & 0xFFFF0000u); }
__device__ __forceinline__ float wave_sum(float v) {
#pragma unroll
    for (int o = 1; o < 64; o <<= 1) v += __shfl_xor(v, o);
    return v;
}
__device__ __forceinline__ float siluf(float v) { return v * __builtin_amdgcn_rcpf(1.f + __expf(-v)); }
__device__ __forceinline__ float softplusf(float v) { return fmaxf(v, 0.f) + log1pf(__expf(-fabsf(v))); }
#define WAVE_SYNC() do { asm volatile("s_waitcnt lgkmcnt(0)" ::: "memory"); __builtin_amdgcn_wave_barrier(); asm volatile("" ::: "memory"); } while (0)
#define MFMA16(a, b, c) __builtin_amdgcn_mfma_f32_16x16x32_bf16((a), (b), (c), 0, 0, 0)
__device__ __forceinline__ void unpack8(const u32x4 v, float* f) {
    f[0] = bflo(v.x); f[1] = bfhi(v.x); f[2] = bflo(v.y); f[3] = bfhi(v.y); f[4] = bflo(v.z); f[5] = bfhi(v.z); f[6] = bflo(v.w); f[7] = bfhi(v.w);
}

namespace pg8 {
constexpr int BM = 256, BK = 64, HALF = 128, HTB = HALF * BK * 2, STAGE_BYTES = 8 * HTB, NXCD = 8, WGM = 8;
__host__ __device__ __forceinline__ int lds_byte(int r, int c) { const int st = (r >> 4) * 2 + (c >> 5), rr = r & 15, cc = c & 31, ob = rr * 64 + cc * 2; return st * 1024 + (ob ^ (((ob >> 9) & 1) << 5)); }
__host__ __device__ __forceinline__ void stage_rc(int b, int& R, int& C) { const int st = b / 1024, sb = b % 1024, swz = sb ^ (((sb >> 9) & 1) << 5); R = (st >> 1) * 16 + swz / 64; C = (st & 1) * 32 + (swz % 64) / 2; }
__host__ __device__ __forceinline__ int perm32(int rho) { const int n = rho >> 4, i = rho & 15; return 8 * (i >> 2) + 4 * n + (i & 3); }
struct Gemm { const bf16_t* A; const bf16_t* Bt; int M, N, K; };
struct StaticOrder {
    int nM, nN, nwg, G, c, nkt, tail;
    __device__ __forceinline__ void init(int M, int N, int K, int G_, int c_, int tail_ = 0) { nM = M / BM; nN = N / BM; nwg = nM * nN; G = G_; c = c_; nkt = K / BK; tail = tail_; }
    __device__ __forceinline__ bool next(int i, int& pm, int& pn, int& k0, int& nk, int& split) const {
        const int L = i * G + c;
        if (L >= nwg) {
            if (!tail || L >= nwg + 256) return false;
            const int j = L - nwg, t = j >> 2, sp = j & 3;
            pm = 128 + (t >> 2); pn = t & 3; split = 1 + sp;
            const int q = (nkt / 4) & ~1, r = (nkt - 4 * q) / 2;
            k0 = sp * q + 2 * (sp < r ? sp : r); nk = q + (sp < r ? 2 : 0);
            return true;
        }
        k0 = 0; nk = nkt; split = 0;
        int wgid = L; { const int q = nwg / NXCD, r = nwg % NXCD, xcd = wgid % NXCD, off = wgid / NXCD; wgid = (xcd < r ? xcd * (q + 1) : r * (q + 1) + (xcd - r) * q) + off; }
        const int nig = WGM * nN, gid = wgid / nig, fm = gid * WGM, gsz = (nM - fm) < WGM ? (nM - fm) : WGM;
        pm = fm + ((wgid % nig) % gsz); pn = (wgid % nig) / gsz; return true;
    }
};
__device__ __forceinline__ unsigned cvt_pk_bf16(float lo, float hi) { return pk2(lo, hi); }

template <class Epi>
__device__ __forceinline__ void gemm_phase(LAS unsigned char* lds, const Gemm g, const StaticOrder& S, const Epi& E) {
    const int tid = otid(), wid = __builtin_amdgcn_readfirstlane(tid >> 6), lane = tid & 63, wr = wid >> 2, wc = wid & 3, fr = lane & 15, fq = lane >> 4;
    const int K = g.K;
    unsigned voffA[2], voffB[2];
#pragma unroll
    for (int i = 0; i < 2; ++i) { int R, C; stage_rc(tid * 16 + i * 8192, R, C); const int Rb = Epi::PERM ? ((R & ~31) + perm32(R & 31)) : R;
        voffA[i] = (unsigned)(R * K + C) * 2u; voffB[i] = (unsigned)(Rb * K + C) * 2u; }
    const size_t kstep = (size_t)(BK * 2);
    const size_t hstep = (size_t)HALF * K * 2;
    const size_t tstep = 2 * hstep;
    const unsigned ldsw = (unsigned)wid * 1024u;
    const int aoff = lds_byte(wr * 64 + fr, fq * 8), boff = lds_byte(wc * 32 + fr, fq * 8);
#define PG8_SA(b, h) (((b) * 2 + (h)) * HTB)
#define PG8_SB(b, h) ((4 + (b) * 2 + (h)) * HTB)
#define PG8_STAGE(bufoff, gbase, voff) do { _Pragma("unroll") for (int _i = 0; _i < 2; ++_i) \
        __builtin_amdgcn_global_load_lds((const unsigned*)((const char*)(gbase) + (voff)[_i]), (LAS unsigned*)(lds + (bufoff) + ldsw + _i * 8192), 16, 0, 0); } while (0)
#define PG8_LDA(dst, b, h) do { _Pragma("unroll") for (int m = 0; m < 4; ++m) _Pragma("unroll") for (int k = 0; k < 2; ++k) dst[m][k] = *(const LAS bf16x8*)(lds + PG8_SA(b, h) + aoff + m * 2048 + k * 1024); } while (0)
#define PG8_LDB(dst, b, h) do { _Pragma("unroll") for (int n = 0; n < 2; ++n) _Pragma("unroll") for (int k = 0; k < 2; ++k) dst[n][k] = *(const LAS bf16x8*)(lds + PG8_SB(b, h) + boff + n * 2048 + k * 1024); } while (0)
#define PG8_MMA(ai, bj, At, Bt) do { __builtin_amdgcn_s_setprio(1); _Pragma("unroll") for (int m = 0; m < 4; ++m) _Pragma("unroll") for (int n = 0; n < 2; ++n) _Pragma("unroll") for (int k = 0; k < 2; ++k) \
        acc[ai][bj][m][n] = __builtin_amdgcn_mfma_f32_16x16x32_bf16(Bt[n][k], At[m][k], acc[ai][bj][m][n], 0, 0, 0); __builtin_amdgcn_s_setprio(0); } while (0)
#define PG8_WAIT_V(n) asm volatile("s_waitcnt vmcnt(" #n ")" ::: "memory")
#define PG8_WAIT_L(n) asm volatile("s_waitcnt lgkmcnt(" #n ")" ::: "memory")
#define PG8_BAR __builtin_amdgcn_s_barrier()
#define PG8_SCHED __builtin_amdgcn_sched_barrier(0)
    int cpm, cpn, ck0, cnk, csp, npm = 0, npn = 0, nk0 = 0, nnk = 0, nsp = 0; int ui = 0;
    if (!S.next(0, cpm, cpn, ck0, cnk, csp)) return;
    f32x4 acc[2][2][4][2];
#pragma unroll
    for (int a = 0; a < 2; ++a)
#pragma unroll
        for (int b = 0; b < 2; ++b)
#pragma unroll
            for (int m = 0; m < 4; ++m)
#pragma unroll
                for (int n = 0; n < 2; ++n) acc[a][b][m][n] = (f32x4){0.f, 0.f, 0.f, 0.f};
    bf16x8 At[4][2], B0[2][2], B1[2][2];
    const char* cA = (const char*)g.A + (size_t)cpm * tstep + (size_t)ck0 * kstep; const char* cB = (const char*)g.Bt + (size_t)cpn * tstep + (size_t)ck0 * kstep;
    PG8_STAGE(PG8_SB(0, 0), cB, voffB); PG8_STAGE(PG8_SA(0, 0), cA, voffA); PG8_STAGE(PG8_SB(0, 1), cB + hstep, voffB); PG8_STAGE(PG8_SA(0, 1), cA + hstep, voffA);
    if (wr == 1) PG8_BAR;
    PG8_WAIT_V(4); PG8_BAR;
    PG8_STAGE(PG8_SB(1, 0), cB + kstep, voffB); PG8_STAGE(PG8_SA(1, 0), cA + kstep, voffA); PG8_STAGE(PG8_SB(1, 1), cB + hstep + kstep, voffB);
    PG8_WAIT_V(6); PG8_BAR;
    for (;;) {
        const bool has_next = S.next(ui + 1, npm, npn, nk0, nnk, nsp);
        const char* nA = has_next ? (const char*)g.A + (size_t)npm * tstep + (size_t)nk0 * kstep : cA; const char* nB = has_next ? (const char*)g.Bt + (size_t)npn * tstep + (size_t)nk0 * kstep : cB;
        const int nt = cnk;
        for (int t = 0; t < nt; t += 2) {
            const bool last = (t == nt - 2);
            const char* a1 = cA + (size_t)(t + 1) * kstep;
            const char* a2 = last ? nA : cA + (size_t)(t + 2) * kstep; const char* b2 = last ? nB : cB + (size_t)(t + 2) * kstep;
            const char* a3 = a2 + kstep; const char* b3 = b2 + kstep;
            PG8_LDB(B0, 0, 0); PG8_SCHED; PG8_LDA(At, 0, 0); PG8_STAGE(PG8_SA(1, 1), a1 + hstep, voffA);
            PG8_WAIT_L(8); PG8_BAR; PG8_WAIT_L(0); PG8_MMA(0, 0, At, B0); PG8_BAR; PG8_SCHED;
            PG8_LDB(B1, 0, 1); PG8_STAGE(PG8_SB(0, 0), b2, voffB);
            PG8_BAR; PG8_WAIT_L(0); PG8_MMA(0, 1, At, B1); PG8_BAR;
            PG8_LDA(At, 0, 1); PG8_STAGE(PG8_SA(0, 0), a2, voffA);
            PG8_BAR; PG8_WAIT_L(0); PG8_MMA(1, 0, At, B0); PG8_BAR; PG8_SCHED;
            PG8_STAGE(PG8_SB(0, 1), b2 + hstep, voffB);
            PG8_WAIT_V(6); PG8_BAR; PG8_MMA(1, 1, At, B1); PG8_BAR;
            PG8_LDB(B0, 1, 0); PG8_SCHED; PG8_LDA(At, 1, 0); PG8_STAGE(PG8_SA(0, 1), a2 + hstep, voffA);
            PG8_WAIT_L(8); PG8_BAR; PG8_WAIT_L(0); PG8_MMA(0, 0, At, B0); PG8_BAR; PG8_SCHED;
            PG8_LDB(B1, 1, 1); PG8_STAGE(PG8_SB(1, 0), b3, voffB);
            PG8_BAR; PG8_WAIT_L(0); PG8_MMA(0, 1, At, B1); PG8_BAR;
            PG8_LDA(At, 1, 1); PG8_STAGE(PG8_SA(1, 0), a3, voffA);
            PG8_BAR; PG8_WAIT_L(0); PG8_MMA(1, 0, At, B0); PG8_BAR; PG8_SCHED;
            PG8_STAGE(PG8_SB(1, 1), b3 + hstep, voffB);
            PG8_WAIT_V(6); PG8_BAR; PG8_MMA(1, 1, At, B1); PG8_BAR;
        }
        E(acc, cpm, cpn, csp, wr, wc, fr, fq);
        if (!has_next) break;
#pragma unroll
        for (int a = 0; a < 2; ++a)
#pragma unroll
            for (int b = 0; b < 2; ++b)
#pragma unroll
                for (int m = 0; m < 4; ++m)
#pragma unroll
                    for (int n = 0; n < 2; ++n) acc[a][b][m][n] = (f32x4){0.f, 0.f, 0.f, 0.f};
        cpm = npm; cpn = npn; ck0 = nk0; cnk = nnk; csp = nsp; cA = nA; cB = nB; ++ui;
    }
    PG8_WAIT_V(0);
    if (wr == 0) PG8_BAR;
    PG8_BAR;
}

struct EpiProj {
    static constexpr bool PERM = true;
    bf16_t* hyproj; bf16_t* proj; float* ab; bf16_t* halo;
    __device__ __forceinline__ void operator()(const f32x4 (&acc)[2][2][4][2], const int upm, const int upn, const int usplit, int wr, int wc, int fr, int fq) const {
        const int row0 = upm * BM + wr * 64 + fr;
#pragma unroll
        for (int ai = 0; ai < 2; ++ai)
#pragma unroll
            for (int m = 0; m < 4; ++m) {
                const size_t row = (size_t)(row0 + ai * HALF + m * 16);
#pragma unroll
                for (int bj = 0; bj < 2; ++bj) {
                    const f32x4 v0 = acc[ai][bj][m][0], v1 = acc[ai][bj][m][1];
                    const int col = upn * BM + bj * HALF + wc * 32 + 8 * fq;
                    if (upn == 15) {
                        if (bj == 0 && wc == 0 && fq < 2) { float* d = ab + row * 16 + 8 * fq; *(f32x4*)d = v0; *(f32x4*)(d + 4) = v1; }
                    } else {
                        u32x4 o; o.x = cvt_pk_bf16(v0[0], v0[1]); o.y = cvt_pk_bf16(v0[2], v0[3]); o.z = cvt_pk_bf16(v1[0], v1[1]); o.w = cvt_pk_bf16(v1[2], v1[3]);
                        bf16_t* d = (upn < 3) ? (hyproj + row * 768 + col) : (proj + row * 3072 + (col - 768));
                        *(u32x4*)d = o;
                        if (upn >= 3 && upn < 9) {
                            if (fr == 0 && m == 0) *(u32x4*)(halo + ((row >> 6) * 2) * 1536 + (col - 768)) = o;
                            if (fr == 15 && m == 3) *(u32x4*)(halo + ((row >> 6) * 2 + 1) * 1536 + (col - 768)) = o;
                        }
                    }
                }
            }
    }
};
struct EpiRes {
    static constexpr bool PERM = false;
    const float* src_lat; const float* src_ctx; float* dst_lat; float* dst_ctx; const float* gate;
    float* slab;
    bf16_t* xb;
    __device__ __forceinline__ void operator()(const f32x4 (&acc)[2][2][4][2], const int upm, const int upn, const int usplit, int wr, int wc, int fr, int fq) const {
        const int row0 = upm * BM + wr * 64 + fr, col0 = upn * BM + wc * 32 + 4 * fq;
        if (usplit) {
            float* sl = slab + ((size_t)(usplit - 1) * NCTX + (row0 - NLAT)) * DM + col0;
#pragma unroll
            for (int ai = 0; ai < 2; ++ai)
#pragma unroll
                for (int m = 0; m < 4; ++m)
#pragma unroll
                    for (int bj = 0; bj < 2; ++bj)
#pragma unroll
                        for (int n = 0; n < 2; ++n) *(f32x4*)(sl + (size_t)(ai * HALF + m * 16) * DM + bj * HALF + n * 16) = acc[ai][bj][m][n];
            return;
        }
        const bool lat = upm * BM < NLAT; const int b = lat ? ((upm * BM) >> 11) : 16;
        const float* gp = gate + (size_t)b * 6144 + col0;
        f32x4 gv[2][2];
#pragma unroll
        for (int bj = 0; bj < 2; ++bj)
#pragma unroll
            for (int n = 0; n < 2; ++n) gv[bj][n] = *(const f32x4*)(gp + bj * HALF + n * 16);
        const float* sb = lat ? src_lat : src_ctx - (size_t)NLAT * DM; float* db = lat ? dst_lat : dst_ctx - (size_t)NLAT * DM;
#pragma unroll
        for (int ai = 0; ai < 2; ++ai)
#pragma unroll
            for (int mh = 0; mh < 2; ++mh) {
                f32x4 xv[2][2][2];
#pragma unroll
                for (int m = 0; m < 2; ++m)
#pragma unroll
                    for (int bj = 0; bj < 2; ++bj)
#pragma unroll
                        for (int n = 0; n < 2; ++n) xv[m][bj][n] = *(const f32x4*)(sb + (size_t)(row0 + ai * HALF + (mh * 2 + m) * 16) * DM + col0 + bj * HALF + n * 16);
                __builtin_amdgcn_sched_barrier(0);
#pragma unroll
                for (int m = 0; m < 2; ++m)
#pragma unroll
                    for (int bj = 0; bj < 2; ++bj)
#pragma unroll
                        for (int n = 0; n < 2; ++n) {
                            const size_t o = (size_t)(row0 + ai * HALF + (mh * 2 + m) * 16) * DM + col0 + bj * HALF + n * 16;
                            const f32x4 r = xv[m][bj][n] + gv[bj][n] * acc[ai][bj][mh * 2 + m][n];
                            *(f32x4*)(db + o) = r;
                            if (xb && lat) { u32x2 pk; pk.x = pk2(r[0], r[1]); pk.y = pk2(r[2], r[3]); *(u32x2*)(xb + o) = pk; }
                        }
            }
    }
};
struct EpiSwiglu {
    static constexpr bool PERM = true;
    bf16_t* hid;
    __device__ __forceinline__ void operator()(const f32x4 (&acc)[2][2][4][2], const int upm, const int upn, const int usplit, int wr, int wc, int fr, int fq) const {
        const int row0 = upm * BM + wr * 64 + fr, col = upn * 128 + wc * 32 + 8 * fq;
#pragma unroll
        for (int ai = 0; ai < 2; ++ai)
#pragma unroll
            for (int m = 0; m < 4; ++m) {
                const size_t row = (size_t)(row0 + ai * HALF + m * 16);
                float r[8];
#pragma unroll
                for (int n = 0; n < 2; ++n)
#pragma unroll
                    for (int j = 0; j < 4; ++j) { const float gv = acc[ai][0][m][n][j], uv = acc[ai][1][m][n][j]; r[n * 4 + j] = gv * __builtin_amdgcn_rcpf(1.f + __expf(-gv)) * uv; }
                u32x4 o; o.x = cvt_pk_bf16(r[0], r[1]); o.y = cvt_pk_bf16(r[2], r[3]); o.z = cvt_pk_bf16(r[4], r[5]); o.w = cvt_pk_bf16(r[6], r[7]);
                *(u32x4*)(hid + row * FFH + col) = o;
            }
    }
};
}

__device__ __forceinline__ int wt_map(int mode, int n) {
    if (mode == 1) return n < 2816 ? n : (n < 2832 ? 3840 + (n - 2816) : n - 16);
    if (mode == 2) { const int j = n < FFH ? n : n - FFH; return (j >> 7) * 256 + (n < FFH ? 0 : 128) + (j & 127); }
    return n;
}
__device__ NOINL void prep_weights(const LAS Params* lp, int l, LAS unsigned char* lds) {
    Params p; LP(w_in); LP(w_out); LP(ffn_w_in); LP(ffn_w_out); LP(Wt_in); LP(Wt_out); LP(Wt_f1); LP(Wt_f2);
    const int tid = otid();
    const int I0 = 16 * 16, I1 = 16 * 4, I2 = 16 * 22, I3 = 44 * 4, NI = I0 + I1 + I2 + I3;
    const float* W; bf16_t* Wt; int K, N, mode, k0, n0;
    auto resolve = [&](int it) {
        int r = it;
        if (r < I0) { W = p.w_in + (size_t)l * DM * INW; K = DM; N = INW; Wt = p.Wt_in; mode = 1; }
        else if ((r -= I0) < I1) { W = p.w_out + (size_t)l * DM * DM; K = DM; N = DM; Wt = p.Wt_out; mode = 0; }
        else if ((r -= I1) < I2) { W = p.ffn_w_in + (size_t)l * DM * 2 * FFH; K = DM; N = 2 * FFH; Wt = p.Wt_f1; mode = 2; }
        else { r -= I2; W = p.ffn_w_out + (size_t)l * FFH * DM; K = FFH; N = DM; Wt = p.Wt_f2; mode = 0; }
        const int ntn = (N + 255) / 256; k0 = (r / ntn) * 64; n0 = (r % ntn) * 256;
    };
    f32x4 v[2][4];
    auto issue = [&]() {
#pragma unroll
        for (int pass = 0; pass < 2; ++pass)
#pragma unroll
            for (int q = 0; q < 4; ++q) {
                const int kk = pass * 32 + (tid >> 4), nn = q * 64 + (tid & 15) * 4;
                v[pass][q] = (n0 + nn < N) ? *(const f32x4*)(W + (size_t)(k0 + kk) * N + n0 + nn) : (f32x4){0.f, 0.f, 0.f, 0.f};
            }
    };
    int it = blockIdx.x, buf = 0;
    __syncthreads();
    if (it < NI) { resolve(it); issue(); }
    for (; it < NI; it += gridDim.x) {
        LAS bf16_t* ts = (LAS bf16_t*)(lds + buf * 36864);
#pragma unroll
        for (int pass = 0; pass < 2; ++pass)
#pragma unroll
            for (int q = 0; q < 4; ++q) {
                const int kk = pass * 32 + (tid >> 4), nn = q * 64 + (tid & 15) * 4;
                ts[(nn + 0) * 72 + kk] = f2bf(v[pass][q][0]); ts[(nn + 1) * 72 + kk] = f2bf(v[pass][q][1]); ts[(nn + 2) * 72 + kk] = f2bf(v[pass][q][2]); ts[(nn + 3) * 72 + kk] = f2bf(v[pass][q][3]);
            }
        const int nn = tid >> 1, k32 = (tid & 1) * 32;
        const bool ok = n0 + nn < N;
        bf16_t* d = Wt + (size_t)wt_map(mode, ok ? n0 + nn : 0) * K + k0 + k32;
        if (it + (int)gridDim.x < NI) { resolve(it + gridDim.x); issue(); }
        __syncthreads();
        if (ok) {
#pragma unroll
            for (int q = 0; q < 4; ++q) *(u32x4*)(d + q * 8) = *(const LAS u32x4*)(ts + nn * 72 + k32 + q * 8);
        }
        buf ^= 1;
    }
    u32x4 z = {0u, 0u, 0u, 0u};
    for (size_t i = (size_t)blockIdx.x * 512 + tid; i < (size_t)240 * DM / 8; i += (size_t)gridDim.x * 512) *(u32x4*)(p.Wt_in + (size_t)3856 * DM + i * 8) = z;
}
__device__ NOINL void prep_mod(const LAS Params* lp, LAS unsigned char* lds) {
    Params p; LP(c); LP(c_ctx); LP(mod_w); LP(mod_b); LP(modbuf);
    LAS float* sc = (LAS float*)lds;
    LAS float* red = (LAS float*)(lds + 17 * 1024 * 4);
    const int tid = otid(), w = tid >> 6, lane = tid & 63;
    bool have = false;
    for (int it = blockIdx.x; it < 2 * 96; it += gridDim.x) {
        const int l = it / 96, n0 = (it % 96) * 64;
        __syncthreads();
        if (!have) { for (int i = tid; i < 17 * 1024; i += 512) { const float v = i < 16 * 1024 ? p.c[i] : p.c_ctx[i - 16 * 1024]; sc[i] = siluf(v); } have = true; __syncthreads(); }
        float acc[17];
#pragma unroll
        for (int r = 0; r < 17; ++r) acc[r] = 0.f;
        const float* wp = p.mod_w + (size_t)l * DM * 6144 + n0 + lane;
#pragma unroll 4
        for (int k = w * 128; k < w * 128 + 128; k += 4) {
            const float w0 = wp[(size_t)k * 6144], w1 = wp[(size_t)(k + 1) * 6144], w2 = wp[(size_t)(k + 2) * 6144], w3 = wp[(size_t)(k + 3) * 6144];
#pragma unroll
            for (int r = 0; r < 17; ++r) { const f32x4 sv = *(const LAS f32x4*)(sc + r * 1024 + k); acc[r] += sv[0] * w0 + sv[1] * w1 + sv[2] * w2 + sv[3] * w3; }
        }
#pragma unroll
        for (int r = 0; r < 17; ++r) red[(w * 17 + r) * 64 + lane] = acc[r];
        __syncthreads();
        for (int i = tid; i < 17 * 64; i += 512) {
            const int r = i >> 6, nn = i & 63; float s = p.mod_b[l * 6144 + n0 + nn];
#pragma unroll
            for (int ww = 0; ww < 8; ++ww) s += red[(ww * 17 + r) * 64 + nn];
            p.modbuf[((size_t)l * 17 + r) * 6144 + n0 + nn] = s;
        }
    }
}
__device__ NOINL void prep_filters(const LAS Params* lp, int l, bool with_ctx, LAS unsigned char* lds) {
    Params p; LP(hy_f_w1); LP(hy_f_b1); LP(hy_f_freq1); LP(hy_f_w2); LP(hy_f_b2); LP(hy_f_freq2); LP(hy_f_w3); LP(Fl); LP(Fc);
    LAS float* zz = (LAS float*)lds;
    LAS float* h1 = zz + 8 * 33;
    LAS float* h2 = h1 + 8 * 64;
    const int tid = otid();
    const float* w1 = p.hy_f_w1 + l * 33 * 64; const float* b1 = p.hy_f_b1 + l * 64; const float* f1 = p.hy_f_freq1 + l * 64;
    const float* w2 = p.hy_f_w2 + l * 64 * 64; const float* b2 = p.hy_f_b2 + l * 64; const float* f2 = p.hy_f_freq2 + l * 64;
    const float* w3 = p.hy_f_w3 + (size_t)l * 64 * 1024;
    const int nit = with_ctx ? 288 : 256;
    for (int it = (blockIdx.x + 64) % gridDim.x; it < nit; it += gridDim.x) {
        const bool isc = it >= 256; const int L = isc ? CTXL : SEQ; const int p0 = (isc ? it - 256 : it) * 8;
        bf16_t* F = isc ? p.Fc : p.Fl;
        __syncthreads();
        if (tid < 264) {
            const int pp = tid / 33, e = tid % 33; const float pos = (float)(p0 + pp);
            float v;
            if (e == 0) v = pos / (float)(L - 1);
            else { const int k = (e - 1) & 15; const float fk = 1e-4f + (float)k * ((15.f - 1e-4f) / 15.f); const float ang = (6.283185307179586f / (float)L) * pos * fk; v = e <= 16 ? cosf(ang) : -sinf(ang); }
            zz[pp * 33 + e] = v;
        }
        __syncthreads();
        { const int pp = tid >> 6, j = tid & 63; float s = b1[j];
#pragma unroll 3
          for (int e = 0; e < 33; ++e) s += zz[pp * 33 + e] * w1[e * 64 + j];
          h1[pp * 64 + j] = sinf(f1[j] * s); }
        __syncthreads();
        { const int pp = tid >> 6, j = tid & 63; float s = b2[j];
#pragma unroll 4
          for (int e = 0; e < 64; ++e) s += h1[pp * 64 + e] * w2[e * 64 + j];
          h2[pp * 64 + j] = sinf(f2[j] * s); }
        __syncthreads();
#pragma unroll 1
        for (int cc = 0; cc < 2; ++cc) {
            const int col = tid + cc * 512;
            float acc[8];
#pragma unroll
            for (int pp = 0; pp < 8; ++pp) acc[pp] = 0.f;
#pragma unroll 4
            for (int j = 0; j < 64; ++j) { const float wv = w3[j * 1024 + col];
#pragma unroll
                for (int pp = 0; pp < 8; ++pp) acc[pp] += h2[pp * 64 + j] * wv; }
            const int order = col >> 9, side = (col >> 8) & 1, c = col & 255;
            const float delta = 3.0701134573253945f + (float)c * ((15.350567286626973f - 3.0701134573253945f) / 255.f);
            bf16_t* Fr = F + ((size_t)order * 256 + c) * (2 * L);
#pragma unroll
            for (int pp = 0; pp < 8; ++pp) {
                const int pos = p0 + pp; const float tpos = (float)pos / (float)(L - 1);
                const float v = acc[pp] * __expf(-tpos * delta);
                if (side == 0) Fr[L - pos] = f2bf(v);
                else if (pos > 0) Fr[L + pos] = f2bf(v);
                else Fr[0] = 0;
            }
        }
    }
}

__device__ NOINL void norm_mod_bf_phase(const bf16_t* xb, int nrows, const float* g, const float* mod  , int si, bf16_t* hb) {
    const int tid = otid(), w = tid >> 6, lane = tid & 63;
    const int stride = gridDim.x * 8;
    for (int row = blockIdx.x * 8 + w; row < nrows; row += 2 * stride) {
        u32x4 q[2][2]; int rows[2] = {row, row + stride};
#pragma unroll
        for (int u = 0; u < 2; ++u)
            if (rows[u] < nrows) {
#pragma unroll
                for (int j = 0; j < 2; ++j) q[u][j] = *(const u32x4*)(xb + (size_t)rows[u] * DM + 8 * lane + 512 * j);
            }
#pragma unroll
        for (int u = 0; u < 2; ++u)
            if (rows[u] < nrows) {
                float v[2][8]; float ss = 0.f;
#pragma unroll
                for (int j = 0; j < 2; ++j) { unpack8(q[u][j], v[j]);
#pragma unroll
                    for (int e = 0; e < 8; ++e) ss += v[j][e] * v[j][e]; }
                const float inv = rsqrtf(wave_sum(ss) * (1.f / DM) + 1e-6f);
                const float* sh = mod + (size_t)(rows[u] >> 11) * 6144 + si * 1024; const float* scp = sh + 1024;
#pragma unroll
                for (int j = 0; j < 2; ++j) {
                    const int c = 8 * lane + 512 * j;
                    float o[8];
#pragma unroll
                    for (int h4 = 0; h4 < 2; ++h4) {
                        const f32x4 gv = *(const f32x4*)(g + c + 4 * h4), sv = *(const f32x4*)(scp + c + 4 * h4), hv = *(const f32x4*)(sh + c + 4 * h4);
#pragma unroll
                        for (int e = 0; e < 4; ++e) o[4 * h4 + e] = v[j][4 * h4 + e] * inv * gv[e] * (1.f + sv[e]) + hv[e];
                    }
                    u32x4 pk; pk.x = pk2(o[0], o[1]); pk.y = pk2(o[2], o[3]); pk.z = pk2(o[4], o[5]); pk.w = pk2(o[6], o[7]);
                    *(u32x4*)(hb + (size_t)rows[u] * DM + c) = pk;
                }
            }
    }
}
__device__ NOINL void norm_mod_phase(const float* lat, const float* ctxp, int nrows, const float* g, const float* mod  , int si, bf16_t* hb,
                                     const float* slab = nullptr  , const float* sgate = nullptr  , float* wb = nullptr  , int first = 0) {
    const int tid = otid(), w = tid >> 6, lane = tid & 63;
    const int stride = gridDim.x * 8;
    for (int row = first + blockIdx.x * 8 + w; row < nrows; row += 2 * stride) {
        f32x4 v[2][4]; float ss[2] = {0.f, 0.f}; int rows[2] = {row, row + stride};
#pragma unroll
        for (int u = 0; u < 2; ++u) {
            if (rows[u] < nrows) {
                const bool il = rows[u] < NLAT;
                const float* xr = il ? lat + (size_t)rows[u] * DM : ctxp + (size_t)(rows[u] - NLAT) * DM;
#pragma unroll
                for (int j = 0; j < 4; ++j) v[u][j] = *(const f32x4*)(xr + 4 * lane + 256 * j);
                if (!il && slab) {
                    const size_t ro = (size_t)(rows[u] - NLAT) * DM;
#pragma unroll
                    for (int j = 0; j < 4; ++j) {
                        const int c = 4 * lane + 256 * j;
                        const f32x4 s0 = *(const f32x4*)(slab + ro + c), s1 = *(const f32x4*)(slab + (size_t)NCTX * DM + ro + c), s2 = *(const f32x4*)(slab + (size_t)2 * NCTX * DM + ro + c), s3 = *(const f32x4*)(slab + (size_t)3 * NCTX * DM + ro + c);
                        v[u][j] += *(const f32x4*)(sgate + c) * ((s0 + s1) + (s2 + s3));
                        if (wb) *(f32x4*)(wb + ro + c) = v[u][j];
                    }
                }
            }
        }
#pragma unroll
        for (int u = 0; u < 2; ++u) {
            if (rows[u] < nrows) {
#pragma unroll
                for (int j = 0; j < 4; ++j) ss[u] += v[u][j][0] * v[u][j][0] + v[u][j][1] * v[u][j][1] + v[u][j][2] * v[u][j][2] + v[u][j][3] * v[u][j][3];
                const float inv = rsqrtf(wave_sum(ss[u]) * (1.f / DM) + 1e-6f);
                const int b = rows[u] < NLAT ? (rows[u] >> 11) : 16;
                const float* sh = mod + (size_t)b * 6144 + si * 1024; const float* scp = sh + 1024;
#pragma unroll
                for (int j = 0; j < 4; ++j) {
                    const int c = 4 * lane + 256 * j;
                    const f32x4 gv = *(const f32x4*)(g + c), sv = *(const f32x4*)(scp + c), hv = *(const f32x4*)(sh + c);
                    float o[4];
#pragma unroll
                    for (int e = 0; e < 4; ++e) o[e] = v[u][j][e] * inv * gv[e] * (1.f + sv[e]) + hv[e];
                    u32x2 pk; pk.x = pk2(o[0], o[1]); pk.y = pk2(o[2], o[3]);
                    *(u32x2*)(hb + (size_t)rows[u] * DM + c) = pk;
                }
            }
        }
    }
}
__device__ NOINL void final_norm_phase(float* xo, const float* g) {
    const int tid = otid(), w = tid >> 6, lane = tid & 63;
    for (int row = blockIdx.x * 8 + w; row < NLAT; row += gridDim.x * 8) {
        float* xr = xo + (size_t)row * DM;
        f32x4 v[4]; float ss = 0.f;
#pragma unroll
        for (int j = 0; j < 4; ++j) { v[j] = *(const f32x4*)(xr + 4 * lane + 256 * j); ss += v[j][0] * v[j][0] + v[j][1] * v[j][1] + v[j][2] * v[j][2] + v[j][3] * v[j][3]; }
        const float inv = rsqrtf(wave_sum(ss) * (1.f / DM) + 1e-6f);
#pragma unroll
        for (int j = 0; j < 4; ++j) { const int c = 4 * lane + 256 * j; const f32x4 gv = *(const f32x4*)(g + c); *(f32x4*)(xr + c) = v[j] * inv * gv; }
    }
}

#define XB_TMO      128
#define XB_XCNT(j)  (256  + 64 * (j))
#define XB_XSUB(j)  (1280 + 64 * (j))
#define XB_XGEN(j)  (2304 + 64 * (j))
#define XB_TOP      3328
#define XB_TOPGEN   3392
#define XCD_BAR_WORDS 3456
#define XB_SPIN_CAP (1u << 18)
__device__ __forceinline__ unsigned xb_ld(unsigned* p)              { return __hip_atomic_load(p, __ATOMIC_RELAXED, __HIP_MEMORY_SCOPE_AGENT); }
__device__ __forceinline__ unsigned xb_add(unsigned* p, unsigned v) { return __hip_atomic_fetch_add(p, v, __ATOMIC_RELAXED, __HIP_MEMORY_SCOPE_AGENT); }
__device__ __forceinline__ unsigned xb_xcc_id() { return (unsigned)__builtin_amdgcn_s_getreg((3 << 11) | 20) & 0xFu; }
#define XB_SPIN(cond, bar) do { unsigned _sp = 0; while (cond) { __builtin_amdgcn_s_sleep(1); \
    if ((++_sp & 255u) == 0u) { if (xb_ld(&(bar)[XB_TMO])) break; if (_sp > XB_SPIN_CAP) { atomicAdd(&(bar)[XB_TMO], 1u); break; } } } } while (0)
struct XcdBarrier { unsigned* bar; unsigned x; volatile LAS unsigned* st; };
__device__ __forceinline__ XcdBarrier xcd_barrier_post(unsigned* bar, volatile LAS unsigned* st) {
    XcdBarrier b; b.bar = bar; b.x = xb_xcc_id(); b.st = st;
    if (threadIdx.x == 0) (void)xb_add(&bar[XB_XCNT(b.x)], 1u);
    return b;
}
__device__ __forceinline__ void xcd_barrier_complete(unsigned* bar, unsigned x, unsigned& nloc, unsigned& nx) {
    const unsigned G = gridDim.x * gridDim.y * gridDim.z;
    unsigned sum, cnt, mine, sp = 0u;
    for (;;) {
        sum = 0u; cnt = 0u; mine = 0u;
#pragma unroll
        for (unsigned j = 0; j < 16; ++j) { const unsigned c = xb_ld(&bar[XB_XCNT(j)]); sum += c; cnt += (c > 0u) ? 1u : 0u; mine = (j == x) ? c : mine; }
        if (sum == G) break;
        __builtin_amdgcn_s_sleep(1);
        if ((++sp & 255u) == 0u) { if (xb_ld(&bar[XB_TMO])) break; if (sp > XB_SPIN_CAP) { atomicAdd(&bar[XB_TMO], 1u); break; } }
    }
    nloc = mine > 0u ? mine : 1u; nx = cnt > 0u ? cnt : 1u;
}
__device__ __forceinline__ void xcd_barrier(const XcdBarrier& b) {
    asm volatile("s_waitcnt vmcnt(0)" ::: "memory");
    __syncthreads();
    if (threadIdx.x == 0) {
        unsigned* bar = b.bar;
        __builtin_amdgcn_s_waitcnt(0);
        unsigned nloc = b.st[0], nx = b.st[1];
        if (nloc == 0u) { xcd_barrier_complete(bar, b.x, nloc, nx); b.st[0] = nloc; b.st[1] = nx; }
        const unsigned old = xb_add(&bar[XB_XSUB(b.x)], 1u);
        const unsigned gen = old / nloc;
        if (old + 1u == (gen + 1u) * nloc) {
            __builtin_amdgcn_fence(__ATOMIC_RELEASE, "agent");
            asm volatile("s_waitcnt vmcnt(0)" ::: "memory");
            const unsigned og = xb_add(&bar[XB_TOP], 1u);
            const unsigned tg = og / nx;
            if (og + 1u == (tg + 1u) * nx) xb_add(&bar[XB_TOPGEN], 1u);
            else XB_SPIN(xb_ld(&bar[XB_TOPGEN]) == tg, bar);
            __builtin_amdgcn_fence(__ATOMIC_ACQUIRE, "agent");
            xb_add(&bar[XB_XGEN(b.x)], 1u);
            asm volatile("s_waitcnt vmcnt(0)" ::: "memory");
        } else {
            XB_SPIN(xb_ld(&bar[XB_XGEN(b.x)]) == gen, bar);
            __builtin_amdgcn_fence(__ATOMIC_ACQUIRE, "agent");
            asm volatile("s_waitcnt vmcnt(0)" ::: "memory");
        }
    }
    __syncthreads();
}

__device__ NOINL void prep_rope(const LAS Params* lp) {
    Params p; LP(ropeT);
    for (int i = blockIdx.x * 512 + otid(); i < SEQ * 32; i += gridDim.x * 512) {
        const int t = i >> 5, a = i & 31;
        const float inv = exp2f(-(float)(a & 15) * (13.287712379549449f / 16.f));
        const float ang = (a < 16 ? (float)(t >> 6) : (float)(t & 63)) * inv;
        float sn, cs; sincosf(ang, &sn, &cs);
        p.ropeT[2 * i] = cs; p.ropeT[2 * i + 1] = sn;
    }
}

__device__ NOINL void h1_phase(const LAS Params* lp, int l, bool with_ctx, LAS unsigned char* lds) {
    Params p; LP(hy_conv_w); LP(hy_conv_b); LP(hyproj); LP(hyT); LP(hyTc);
    LAS float* cwl = (LAS float*)(lds + 73728);
    const int tid = otid();
    __syncthreads();
    for (int i = tid; i < 4 * 768; i += 512) cwl[i] = i < 2304 ? p.hy_conv_w[l * 2304 + i] : p.hy_conv_b[l * 768 + i - 2304];
    __syncthreads();
    const int nit = ((with_ctx ? NTOK : NLAT) / 64) * 3;
    const int tk = tid >> 3, c8 = (tid & 7) * 8;
    u32x4 r0[4], r1[4], r2[4];
    auto issue = [&](int it) {
        const int tt = it / 3, c0 = (it % 3) * 256, row0 = tt * 64;
        const bool il = row0 < NLAT; const int L = il ? SEQ : CTXL;
        const int t = (il ? row0 % SEQ : (row0 - NLAT) % CTXL) + tk;
        const u32x4 z = {0u, 0u, 0u, 0u};
#pragma unroll
        for (int q = 0; q < 4; ++q) {
            const bf16_t* src = p.hyproj + (size_t)(row0 + tk) * 768 + c0 + q * 64 + c8;
            r0[q] = t > 0 ? *(const u32x4*)(src - 768) : z; r1[q] = *(const u32x4*)src; r2[q] = t < L - 1 ? *(const u32x4*)(src + 768) : z;
        }
    };
    int it = blockIdx.x, buf = 0;
    if (it < nit) issue(it);
    for (; it < nit; it += gridDim.x) {
        const int tt = it / 3, c0 = (it % 3) * 256, row0 = tt * 64;
        const bool il = row0 < NLAT;
        const int b = il ? row0 / SEQ : (row0 - NLAT) / CTXL, t0 = il ? row0 % SEQ : (row0 - NLAT) % CTXL;
        LAS bf16_t* ts = (LAS bf16_t*)(lds + buf * 36864);
#pragma unroll
        for (int q = 0; q < 4; ++q) {
            const int ch = c0 + q * 64 + c8;
            float a0[8], a1[8], a2[8]; unpack8(r0[q], a0); unpack8(r1[q], a1); unpack8(r2[q], a2);
#pragma unroll
            for (int e4 = 0; e4 < 2; ++e4) {
                const f32x4 w0 = *(const LAS f32x4*)(cwl + ch + e4 * 4), w1 = *(const LAS f32x4*)(cwl + 768 + ch + e4 * 4), w2 = *(const LAS f32x4*)(cwl + 1536 + ch + e4 * 4), wb = *(const LAS f32x4*)(cwl + 2304 + ch + e4 * 4);
#pragma unroll
                for (int u = 0; u < 4; ++u) { const int e = e4 * 4 + u; ts[(q * 64 + c8 + e) * 72 + tk] = f2bf(w0[u] * a0[e] + w1[u] * a1[e] + w2[u] * a2[e] + wb[u]); }
            }
        }
        if (it + (int)gridDim.x < nit) issue(it + gridDim.x);
        __syncthreads();
        {
            const int chl = tid >> 1, hf = tid & 1;
            bf16_t* dst = il ? p.hyT + ((size_t)(c0 + chl) * NB + b) * SEQ + t0 + hf * 32 : p.hyTc + ((size_t)(c0 + chl) * NB + b) * CTXL + t0 + hf * 32;
#pragma unroll
            for (int q = 0; q < 4; ++q) *(u32x4*)(dst + q * 8) = *(const LAS u32x4*)(ts + chl * 72 + hf * 32 + q * 8);
        }
        buf ^= 1;
    }
}

__device__ __forceinline__ void chunk_geom(int b, int cid, int& row0, int& t0, int& L) {
    if (cid < 4) { row0 = NLAT + b * CTXL + cid * 64; t0 = cid * 64; L = CTXL; } else { row0 = b * SEQ + (cid - 4) * 64; t0 = (cid - 4) * 64; L = SEQ; }
}
__device__ __forceinline__ void conv16p(const bf16_t* pc, const bf16_t* pp, const bf16_t* pn, const LAS float* w  , float* out) {
    const u32x4 z = {0u, 0u, 0u, 0u};
#pragma unroll
    for (int hh = 0; hh < 2; ++hh) {
        const u32x4 r0 = pp ? *(const u32x4*)(pp + hh * 8) : z, r1 = *(const u32x4*)(pc + hh * 8), r2 = pn ? *(const u32x4*)(pn + hh * 8) : z;
        float a0[8], a1[8], a2[8]; unpack8(r0, a0); unpack8(r1, a1); unpack8(r2, a2);
#pragma unroll
        for (int q = 0; q < 2; ++q) {
            const f32x4 w0 = *(const LAS f32x4*)(w + hh * 8 + q * 4), w1 = *(const LAS f32x4*)(w + 128 + hh * 8 + q * 4), w2 = *(const LAS f32x4*)(w + 256 + hh * 8 + q * 4);
#pragma unroll
            for (int e = 0; e < 4; ++e) out[hh * 8 + q * 4 + e] = w0[e] * a0[q * 4 + e] + w1[e] * a1[q * 4 + e] + w2[e] * a2[q * 4 + e];
        }
    }
}
__device__ __forceinline__ void pack16(const float* v, float sc, u32x4& o0, u32x4& o1) {
    o0.x = pk2(v[0] * sc, v[1] * sc); o0.y = pk2(v[2] * sc, v[3] * sc); o0.z = pk2(v[4] * sc, v[5] * sc); o0.w = pk2(v[6] * sc, v[7] * sc);
    o1.x = pk2(v[8] * sc, v[9] * sc); o1.y = pk2(v[10] * sc, v[11] * sc); o1.z = pk2(v[12] * sc, v[13] * sc); o1.w = pk2(v[14] * sc, v[15] * sc);
}

__device__ NOINL void qkvn_phase(const LAS Params* lp, int l, LAS unsigned char* lds) {
    Params p; LP(proj); LP(halo); LP(gdn_conv_w); LP(ropeT);
    const int tid = otid(), tk = tid >> 3, cg8 = tid & 7;
    const float* gcw = p.gdn_conv_w + (size_t)l * 3 * 1536;
    constexpr int NT = NTOK / 64;
    LAS float* cwl = (LAS float*)(lds + 86016);
    int curh = -1;
    u32x4 raw[3][3][2];
    auto issue = [&](int it, int tn) {
        const int tt = it >> 2, h = it & 3, row0 = tt * 64;
        const bool il = row0 < NLAT; const int L = il ? SEQ : CTXL; const int t = (il ? row0 % SEQ : (row0 - NLAT) % CTXL) + tk;
        const int col = tn * 512 + h * 128 + cg8 * 16;
        const bf16_t* pc = p.proj + (size_t)(row0 + tk) * 3072 + col;
        const bf16_t* pp = tk > 0 ? pc - 3072 : (t > 0 ? p.halo + ((size_t)(tt - 1) * 2 + 1) * 1536 + col : nullptr);
        const bf16_t* pn = tk < 63 ? pc + 3072 : (t < L - 1 ? p.halo + ((size_t)(tt + 1) * 2) * 1536 + col : nullptr);
        const u32x4 z = {0u, 0u, 0u, 0u};
#pragma unroll
        for (int hh = 0; hh < 2; ++hh) { raw[tn][0][hh] = pp ? *(const u32x4*)(pp + hh * 8) : z; raw[tn][1][hh] = *(const u32x4*)(pc + hh * 8); raw[tn][2][hh] = pn ? *(const u32x4*)(pn + hh * 8) : z; }
    };
    int it = blockIdx.x;
    if (it < NT * 4) { issue(it, 0); issue(it, 1); issue(it, 2); }
    for (; it < NT * 4; it += gridDim.x) {
        const int tt = it >> 2, h = it & 3, row0 = tt * 64;
        if (h != curh) {
            __syncthreads();
            for (int i = tid; i < 1152; i += 512) { const int tn = i / 384, j = (i / 128) % 3, cc = i & 127; cwl[i] = gcw[j * 1536 + tn * 512 + h * 128 + cc]; }
            __syncthreads();
            curh = h;
        }
        const bool more = it + (int)gridDim.x < NT * 4;
        u32x4 o[3][2];
#pragma unroll
        for (int tn = 0; tn < 3; ++tn) {
            float v[16];
            const LAS float* w = cwl + tn * 384 + cg8 * 16;
#pragma unroll
            for (int hh = 0; hh < 2; ++hh) {
                float a0[8], a1[8], a2[8]; unpack8(raw[tn][0][hh], a0); unpack8(raw[tn][1][hh], a1); unpack8(raw[tn][2][hh], a2);
#pragma unroll
                for (int q = 0; q < 2; ++q) {
                    const f32x4 w0 = *(const LAS f32x4*)(w + hh * 8 + q * 4), w1 = *(const LAS f32x4*)(w + 128 + hh * 8 + q * 4), w2 = *(const LAS f32x4*)(w + 256 + hh * 8 + q * 4);
#pragma unroll
                    for (int e = 0; e < 4; ++e) v[hh * 8 + q * 4 + e] = w0[e] * a0[q * 4 + e] + w1[e] * a1[q * 4 + e] + w2[e] * a2[q * 4 + e];
                }
            }
            if (more) issue(it + gridDim.x, tn);
            float ss = 0.f;
#pragma unroll
            for (int e = 0; e < 16; ++e) { v[e] = siluf(v[e]); ss += v[e] * v[e]; }
            float sc = 1.f;
            if (tn < 2) { ss += __shfl_xor(ss, 1); ss += __shfl_xor(ss, 2); ss += __shfl_xor(ss, 4); sc = rsqrtf(ss + 1e-6f) * (tn == 0 ? 0.08838834764831845f : 1.f); }
            pack16(v, sc, o[tn][0], o[tn][1]);
        }
        __syncthreads();
#pragma unroll
        for (int tn = 0; tn < 3; ++tn) { bf16_t* d = p.proj + (size_t)(row0 + tk) * 3072 + tn * 512 + h * 128 + cg8 * 16; *(u32x4*)d = o[tn][0]; *(u32x4*)(d + 8) = o[tn][1]; }
    }
    for (int tt = blockIdx.x; tt < NT; tt += gridDim.x) {
        const int row0 = tt * 64, hd = cg8 >> 1, i0 = (cg8 & 1) * 16;
        const bool il = row0 < NLAT; const int t = (row0 % SEQ) + tk;
        bf16_t* qp = p.proj + (size_t)(row0 + tk) * 3072 + 2048 + hd * 64 + i0; bf16_t* kp = qp + 256;
        float q1[16], q2[16], k1[16], k2[16];
        unpack8(*(const u32x4*)qp, q1); unpack8(*(const u32x4*)(qp + 8), q1 + 8); unpack8(*(const u32x4*)(qp + 32), q2); unpack8(*(const u32x4*)(qp + 40), q2 + 8);
        unpack8(*(const u32x4*)kp, k1); unpack8(*(const u32x4*)(kp + 8), k1 + 8); unpack8(*(const u32x4*)(kp + 32), k2); unpack8(*(const u32x4*)(kp + 40), k2 + 8);
        float qa[16], qb[16], ka[16], kb[16];
#pragma unroll
        for (int e2 = 0; e2 < 8; ++e2) {
            f32x4 cs4 = {1.f, 0.f, 1.f, 0.f};
            if (il) cs4 = *(const f32x4*)(p.ropeT + ((size_t)t * 32 + i0 + 2 * e2) * 2);
#pragma unroll
            for (int u = 0; u < 2; ++u) {
                const int e = 2 * e2 + u; const float cs = cs4[2 * u], sn = cs4[2 * u + 1];
                qa[e] = q1[e] * cs - q2[e] * sn; qb[e] = q1[e] * sn + q2[e] * cs;
                ka[e] = (k1[e] * cs - k2[e] * sn) * 0.125f; kb[e] = (k1[e] * sn + k2[e] * cs) * 0.125f;
            }
        }
        u32x4 o0, o1;
        pack16(qa, 1.f, o0, o1); *(u32x4*)qp = o0; *(u32x4*)(qp + 8) = o1;
        pack16(qb, 1.f, o0, o1); *(u32x4*)(qp + 32) = o0; *(u32x4*)(qp + 40) = o1;
        pack16(ka, 1.f, o0, o1); *(u32x4*)kp = o0; *(u32x4*)(kp + 8) = o1;
        pack16(kb, 1.f, o0, o1); *(u32x4*)(kp + 32) = o0; *(u32x4*)(kp + 40) = o1;
    }
}

__device__ NOINL void g1_phase(const LAS Params* lp, int l, LAS unsigned char* lds) {
    Params p; LP(proj); LP(ab); LP(gdn_a_log); LP(gdn_dt_bias); LP(Tbuf); LP(gcbuf);
    constexpr int SLOT = 51200;
    const int tid = otid(), w = tid >> 6, lane = tid & 63, fr = lane & 15, fq = lane >> 4;
    for (int it = blockIdx.x; it < NB * 4 * 12; it += gridDim.x) {
        const int b = it / 48, h = (it / 12) & 3, c3 = it % 12;
        __syncthreads();
        {
            const int tk = tid >> 3, cg8 = tid & 7;
#pragma unroll
            for (int s = 0; s < 3; ++s) {
                int row0, t0, L; chunk_geom(b, c3 * 3 + s, row0, t0, L);
                const bf16_t* src = p.proj + (size_t)(row0 + tk) * 3072 + 512 + h * 128 + cg8 * 16;
                LAS bf16_t* Kn = (LAS bf16_t*)(lds + s * SLOT);
                *(LAS u32x4*)(Kn + tk * 136 + cg8 * 16) = *(const u32x4*)src; *(LAS u32x4*)(Kn + tk * 136 + cg8 * 16 + 8) = *(const u32x4*)(src + 8);
            }
        }
        if (w < 6) {
            const int s = w >> 1, dir = w & 1, tk = dir ? 63 - lane : lane;
            int row0, t0, L; chunk_geom(b, c3 * 3 + s, row0, t0, L);
            const float a = p.ab[(size_t)(row0 + tk) * 16 + dir * 4 + h], bb = p.ab[(size_t)(row0 + tk) * 16 + 8 + dir * 4 + h];
            float g = -__expf(p.gdn_a_log[l * 8 + dir * 4 + h]) * softplusf(a + p.gdn_dt_bias[l * 8 + dir * 4 + h]);
#pragma unroll
            for (int o = 1; o < 64; o <<= 1) { const float t = __shfl_up(g, o); if (lane >= o) g += t; }
            LAS float* gcs = (LAS float*)(lds + s * SLOT + 17408);
            const float be = __builtin_amdgcn_rcpf(1.f + __expf(-bb));
            gcs[dir * 64 + lane] = g; gcs[128 + dir * 64 + lane] = be;
            float* gb = p.gcbuf + ((((size_t)b * 4 + h) * 36 + c3 * 3 + s) * 2 + dir) * 192;
            gb[lane] = g; gb[64 + lane] = be; gb[128 + lane] = __expf(g);
        }
        __syncthreads();
#pragma unroll 1
        for (int q = 0; q < 6; ++q) {
            const int tix = w * 6 + q, s = tix >> 4, itl = (tix >> 2) & 3, jt = tix & 3;
            const LAS bf16_t* Kn = (const LAS bf16_t*)(lds + s * SLOT);
            const LAS float* gcs = (const LAS float*)(lds + s * SLOT + 17408);
            LAS float* Lm = (LAS float*)(lds + s * SLOT + 18432);
            f32x4 acc = {0.f, 0.f, 0.f, 0.f};
#pragma unroll
            for (int ks = 0; ks < 4; ++ks) {
                const bf16x8 A = *(const LAS bf16x8*)(Kn + (16 * itl + fr) * 136 + ks * 32 + fq * 8), B = *(const LAS bf16x8*)(Kn + (16 * jt + fr) * 136 + ks * 32 + fq * 8);
                acc = MFMA16(A, B, acc);
            }
            const int jj = 16 * jt + fr;
#pragma unroll
            for (int j = 0; j < 4; ++j) {
                const int i = 16 * itl + 4 * fq + j;
                const float v0 = jj < i ? gcs[128 + i] * acc[j] * __expf(gcs[i] - gcs[jj]) : 0.f;
                const int p1 = 63 - i, pp1 = 63 - jj;
                const float v1 = jj > i ? gcs[192 + p1] * acc[j] * __expf(gcs[64 + p1] - gcs[64 + pp1]) : 0.f;
                Lm[i * 64 + jj] = v0; Lm[4096 + p1 * 64 + pp1] = v1;
            }
        }
        __syncthreads();
        if (w < 6) {
            const int s = w >> 1, dir = w & 1;
            const LAS float* Ld = (const LAS float*)(lds + s * SLOT + 18432) + dir * 4096;
            float xv[64];
#pragma unroll
            for (int i = 0; i < 64; ++i) {
                float s0 = (i == lane) ? 1.f : 0.f, s1 = 0.f, s2 = 0.f, s3 = 0.f;
#pragma unroll
                for (int j4 = 0; j4 < (i + 3) / 4; ++j4) {
                    const f32x4 lv = *(const LAS f32x4*)(Ld + i * 64 + j4 * 4);
                    if (j4 * 4 + 0 < i) s0 -= lv[0] * xv[j4 * 4 + 0];
                    if (j4 * 4 + 1 < i) s1 -= lv[1] * xv[j4 * 4 + 1];
                    if (j4 * 4 + 2 < i) s2 -= lv[2] * xv[j4 * 4 + 2];
                    if (j4 * 4 + 3 < i) s3 -= lv[3] * xv[j4 * 4 + 3];
                }
                xv[i] = (s0 + s1) + (s2 + s3);
            }
            bf16_t* Tg = p.Tbuf + ((((size_t)b * 4 + h) * 36 + c3 * 3 + s) * 2 + dir) * 4096;
#pragma unroll
            for (int i = 0; i < 64; ++i) Tg[i * 64 + lane] = f2bf(xv[i]);
        }
    }
}

constexpr int CH_Q = 0, CH_K = 17408, CH_KT = 34816, CH_VT = 53248, CH_TT = 71680, CH_AT = 80896, CH_WP = 99328, CH_GC = 152576;
template <int MODE>
__device__ NOINL void chain_item(const LAS Params* lp, int l, int item, bool ctx_out, LAS unsigned char* lds) {
    Params p; LP(proj); LP(Tbuf); LP(hbuf); LP(hyproj); LP(ret_decay_logit); LP(gcbuf);
    LAS bf16_t* Qs = (LAS bf16_t*)(lds + CH_Q);
    LAS bf16_t* Ks = (LAS bf16_t*)(lds + CH_K);
    LAS bf16_t* KT = (LAS bf16_t*)(lds + CH_KT);
    LAS bf16_t* VT = (LAS bf16_t*)(lds + CH_VT);
    LAS bf16_t* TT = (LAS bf16_t*)(lds + CH_TT);
    LAS bf16_t* AT = (LAS bf16_t*)(lds + CH_AT);
    LAS float* gcs = (LAS float*)(lds + CH_GC);
    LAS float* bts = gcs + 64;
    const int tid = otid(), w = tid >> 6, lane = tid & 63, fr = lane & 15, fq = lane >> 4;
    LAS bf16_t* ST = (LAS bf16_t*)(lds + CH_WP + w * 6656);
    LAS bf16_t* RP = (LAS bf16_t*)(lds + CH_WP + w * 6656 + 4352);
    int b, h, dir;
    if (MODE == 0) { b = item >> 3; h = (item >> 1) & 3; dir = item & 1; } else { b = item >> 2; h = ((item >> 1) & 1) * 2; dir = item & 1; }
    constexpr int NDK = MODE == 0 ? 8 : 4;
    constexpr int NKS = MODE == 0 ? 4 : 2;
    const int hh = MODE == 0 ? 0 : (w >> 2);
    const int dvrow = MODE == 0 ? 16 * w : 64 * hh + 16 * (w & 3);
    const int kcol = MODE == 0 ? 0 : 64 * hh;
    float lg = 0.f;
    if (MODE == 1) { const float xl = p.ret_decay_logit[l * 8 + dir * 4 + h + hh]; lg = -softplusf(-xl); }
    f32x4 Sacc[NDK];
#pragma unroll
    for (int i = 0; i < NDK; ++i) Sacc[i] = (f32x4){0.f, 0.f, 0.f, 0.f};
    const int tk = tid >> 3, cg8 = tid & 7, pp = dir ? 63 - tk : tk;
    const int ppz = (((pp >> 3) ^ cg8) << 3) | (pp & 7);
    const int vkey = (dvrow >> 4) & 7;
    const int lcol = MODE == 0 ? h * 128 + cg8 * 16 : 2048 + (h + (cg8 >> 2)) * 64 + (cg8 & 3) * 16;
    const int lstep = MODE == 0 ? 512 : 256;
    const int lrow = MODE == 0 ? cg8 * 16 : (cg8 >> 2) * 64 + (cg8 & 3) * 16;
    float lgl = 0.f;
    if (MODE == 1) lgl = -softplusf(-p.ret_decay_logit[l * 8 + dir * 4 + h + (cg8 >> 2)]);
    u32x4 rq[2], rk[2], rv[2], rt; float rg = 0.f;
    auto issue = [&](int n) {
        const int cid = n < 4 ? (dir ? 3 - n : n) : (dir ? 39 - n : n);
        int row0, t0, L; chunk_geom(b, cid, row0, t0, L);
        const bf16_t* src = p.proj + (size_t)(row0 + tk) * 3072 + lcol;
        rq[0] = *(const u32x4*)src; rq[1] = *(const u32x4*)(src + 8);
        rk[0] = *(const u32x4*)(src + lstep); rk[1] = *(const u32x4*)(src + lstep + 8);
        rv[0] = *(const u32x4*)(src + 2 * lstep); rv[1] = *(const u32x4*)(src + 2 * lstep + 8);
        if (MODE == 0) {
            rt = *(const u32x4*)(p.Tbuf + ((((size_t)b * 4 + h) * 36 + cid) * 2 + dir) * 4096 + tid * 8);
            if (tid < 192) rg = p.gcbuf[((((size_t)b * 4 + h) * 36 + cid) * 2 + dir) * 192 + tid];
        }
    };
    issue(0);
    for (int n = 0; n < 36; ++n) {
        const int cid = n < 4 ? (dir ? 3 - n : n) : (dir ? 39 - n : n);
        int row0, t0, L; chunk_geom(b, cid, row0, t0, L);
        __syncthreads();
        u32x4 kk0 = rk[0], kk1 = rk[1];
        *(LAS u32x4*)(Qs + pp * 136 + lrow) = rq[0]; *(LAS u32x4*)(Qs + pp * 136 + lrow + 8) = rq[1];
        *(LAS u32x4*)(Ks + pp * 136 + lrow) = kk0; *(LAS u32x4*)(Ks + pp * 136 + lrow + 8) = kk1;
        {
            const unsigned vv[8] = {rv[0].x, rv[0].y, rv[0].z, rv[0].w, rv[1].x, rv[1].y, rv[1].z, rv[1].w};
#pragma unroll
            for (int e = 0; e < 8; ++e) { VT[(lrow + 2 * e) * 72 + ppz] = (bf16_t)(vv[e] & 0xFFFFu); VT[(lrow + 2 * e + 1) * 72 + ppz] = (bf16_t)(vv[e] >> 16); }
        }
        if (MODE == 0) {
            *(LAS u32x4*)(TT + (tid >> 3) * 72 + (tid & 7) * 8) = rt;
            if (tid < 192) gcs[tid] = rg;
        } else {
            const float ksc = __expf((float)(63 - pp) * lgl);
            float kf[16]; unpack8(kk0, kf); unpack8(kk1, kf + 8);
#pragma unroll
            for (int e = 0; e < 16; ++e) KT[(lrow + e) * 72 + ppz] = f2bf(kf[e] * ksc);
        }
        __syncthreads();
        if (n + 1 < 36) issue(n + 1);
        if (MODE == 0) {
            const float sc = __expf(gcs[63] - gcs[pp]);
            {
                float kf[16]; unpack8(kk0, kf); unpack8(kk1, kf + 8);
#pragma unroll
                for (int e = 0; e < 16; ++e) KT[(lrow + e) * 72 + ppz] = f2bf(kf[e] * sc);
            }
            const int ct = w >> 1;
#pragma unroll
            for (int jj = 0; jj < 2; ++jj) {
                const int st = 2 * (w & 1) + jj; f32x4 acc = {0.f, 0.f, 0.f, 0.f};
#pragma unroll
                for (int ks = 0; ks < 4; ++ks) {
                    const bf16x8 A = *(const LAS bf16x8*)(Qs + (16 * ct + fr) * 136 + ks * 32 + fq * 8), B = *(const LAS bf16x8*)(Ks + (16 * st + fr) * 136 + ks * 32 + fq * 8);
                    acc = MFMA16(A, B, acc);
                }
                const int s = 16 * st + fr; const float gs = gcs[s];
#pragma unroll
                for (int j = 0; j < 4; ++j) { const int c = 16 * ct + 4 * fq + j; AT[c * 72 + s] = f2bf(s <= c ? acc[j] * __expf(gcs[c] - gs) : 0.f); }
            }
        } else {
            const int ct = w & 3;
#pragma unroll
            for (int st = 0; st < 4; ++st) {
                f32x4 acc = {0.f, 0.f, 0.f, 0.f};
#pragma unroll
                for (int ks = 0; ks < 2; ++ks) {
                    const bf16x8 A = *(const LAS bf16x8*)(Qs + (16 * ct + fr) * 136 + kcol + ks * 32 + fq * 8), B = *(const LAS bf16x8*)(Ks + (16 * st + fr) * 136 + kcol + ks * 32 + fq * 8);
                    acc = MFMA16(A, B, acc);
                }
                const int s = 16 * st + fr;
#pragma unroll
                for (int j = 0; j < 4; ++j) { const int c = 16 * ct + 4 * fq + j; AT[hh * 4608 + c * 72 + s] = f2bf(s <= c ? acc[j] * __expf((float)(c - s) * lg) : 0.f); }
            }
        }
        __syncthreads();
#pragma unroll
        for (int dk = 0; dk < NDK; ++dk) { u32x2 pk; pk.x = pk2(Sacc[dk][0], Sacc[dk][1]); pk.y = pk2(Sacc[dk][2], Sacc[dk][3]); *(LAS u32x2*)(ST + fr * 136 + 16 * dk + 4 * fq) = pk; }
        WAVE_SYNC();
        f32x4 qs[4], ksm[4];
#pragma unroll
        for (int ct = 0; ct < 4; ++ct) { qs[ct] = (f32x4){0.f, 0.f, 0.f, 0.f}; ksm[ct] = (f32x4){0.f, 0.f, 0.f, 0.f}; }
#pragma unroll
        for (int ks = 0; ks < NKS; ++ks) {
            const bf16x8 Bf = *(const LAS bf16x8*)(ST + fr * 136 + ks * 32 + fq * 8);
#pragma unroll
            for (int ct = 0; ct < 4; ++ct) {
                const bf16x8 Aq = *(const LAS bf16x8*)(Qs + (16 * ct + fr) * 136 + kcol + ks * 32 + fq * 8);
                qs[ct] = MFMA16(Aq, Bf, qs[ct]);
                if (MODE == 0) { const bf16x8 Ak = *(const LAS bf16x8*)(Ks + (16 * ct + fr) * 136 + ks * 32 + fq * 8); ksm[ct] = MFMA16(Ak, Bf, ksm[ct]); }
            }
        }
        float eg[4][4];
#pragma unroll
        for (int ct = 0; ct < 4; ++ct)
#pragma unroll
            for (int j = 0; j < 4; ++j) { const int c = 16 * ct + 4 * fq + j; eg[ct][j] = MODE == 0 ? gcs[128 + c] : __expf((float)(c + 1) * lg); }
        bf16x8 Bv[2];
        if (MODE == 0) {
#pragma unroll
            for (int ct = 0; ct < 4; ++ct) {
                const u32x2 vv = *(const LAS u32x2*)(VT + (dvrow + fr) * 72 + (((2 * ct + (fq >> 1)) ^ vkey) << 3) + 4 * (fq & 1));
                const float v4[4] = {bflo(vv.x), bfhi(vv.x), bflo(vv.y), bfhi(vv.y)};
                float r[4];
#pragma unroll
                for (int j = 0; j < 4; ++j) r[j] = bts[16 * ct + 4 * fq + j] * (v4[j] - eg[ct][j] * ksm[ct][j]);
                u32x2 pk; pk.x = pk2(r[0], r[1]); pk.y = pk2(r[2], r[3]);
                *(LAS u32x2*)(RP + fr * 72 + 16 * ct + 4 * fq) = pk;
            }
            WAVE_SYNC();
            bf16x8 Br[2];
            Br[0] = *(const LAS bf16x8*)(RP + fr * 72 + fq * 8); Br[1] = *(const LAS bf16x8*)(RP + fr * 72 + 32 + fq * 8);
            f32x4 vn[4];
#pragma unroll
            for (int ct = 0; ct < 4; ++ct) {
                vn[ct] = (f32x4){0.f, 0.f, 0.f, 0.f};
#pragma unroll
                for (int ks = 0; ks < 2; ++ks) { const bf16x8 A = *(const LAS bf16x8*)(TT + (16 * ct + fr) * 72 + ks * 32 + fq * 8); vn[ct] = MFMA16(A, Br[ks], vn[ct]); }
            }
            WAVE_SYNC();
#pragma unroll
            for (int ct = 0; ct < 4; ++ct) { u32x2 pk; pk.x = pk2(vn[ct][0], vn[ct][1]); pk.y = pk2(vn[ct][2], vn[ct][3]); *(LAS u32x2*)(RP + fr * 72 + 16 * ct + 4 * fq) = pk; }
            WAVE_SYNC();
            Bv[0] = *(const LAS bf16x8*)(RP + fr * 72 + fq * 8); Bv[1] = *(const LAS bf16x8*)(RP + fr * 72 + 32 + fq * 8);
        } else {
            Bv[0] = *(const LAS bf16x8*)(VT + (dvrow + fr) * 72 + ((fq ^ vkey) << 3)); Bv[1] = *(const LAS bf16x8*)(VT + (dvrow + fr) * 72 + (((4 + fq) ^ vkey) << 3));
        }
        {
            typedef __attribute__((address_space(1))) bf16_t gbf16;
            bf16_t* ob; int ldo;
            if (MODE == 0) { if (dir == 0) { ob = p.hbuf + 256 + h * 128 + 16 * w; ldo = 1024; } else { ob = p.hyproj + h * 128 + 16 * w; ldo = 768; } }
            else { if (dir == 0) { ob = p.hbuf + 768 + (h + hh) * 64 + 16 * (w & 3); ldo = 1024; } else { ob = p.hyproj + 512 + (h + hh) * 64 + 16 * (w & 3); ldo = 768; } }
#pragma unroll
            for (int ct = 0; ct < 4; ++ct) {
                f32x4 acc = {0.f, 0.f, 0.f, 0.f};
#pragma unroll
                for (int ks = 0; ks < 2; ++ks) { const bf16x8 A = *(const LAS bf16x8*)(AT + hh * 4608 + (16 * ct + fr) * 72 + ks * 32 + fq * 8); acc = MFMA16(A, Bv[ks], acc); }
                gbf16* og = (gbf16*)ob + (size_t)row0 * ldo + fr;
#pragma unroll
                for (int j = 0; j < 4; ++j) { const int c = 16 * ct + 4 * fq + j, tok = dir ? 63 - c : c; og[tok * ldo] = f2bf(eg[ct][j] * qs[ct][j] + acc[j]); }
            }
        }
        {
            const float gl = MODE == 0 ? gcs[128 + 63] : __expf(64.f * lg);
#pragma unroll
            for (int dk = 0; dk < NDK; ++dk) {
                Sacc[dk] = Sacc[dk] * gl;
#pragma unroll
                for (int ks = 0; ks < 2; ++ks) { const bf16x8 A = *(const LAS bf16x8*)(KT + (kcol + 16 * dk + fr) * 72 + (((ks * 4 + fq) ^ (((kcol >> 4) + dk) & 7)) << 3)); Sacc[dk] = MFMA16(A, Bv[ks], Sacc[dk]); }
            }
        }
    }
}

template <int L>
__device__ NOINL void hyena_item(const LAS Params* lp, int l, int c, LAS unsigned char* lds) {
    Params p; LP(Fl); LP(Fc); LP(hyT); LP(hyTc); LP(hy_bias); LP(hyO); LP(hyOc);
    constexpr int NTB = L / 128, NS = L / 32, FSB = (2 * L + 16) * 2, USB = (L + 8) * 2, UOFF = 8 * FSB;
    const int tid = otid(), w = tid >> 6, lane = tid & 63, fr = lane & 15, fq = lane >> 4;
    const bf16_t* Fg = (L == SEQ ? p.Fl : p.Fc);
    const bf16_t* hT = (L == SEQ ? p.hyT : p.hyTc);
    bf16_t* hO = (L == SEQ ? p.hyO : p.hyOc);
    const float bias0 = p.hy_bias[l * 512 + c], bias1 = p.hy_bias[l * 512 + 256 + c];
    __syncthreads();
    for (int i = tid; i < 16 * L / 8; i += 512) { const int bb = i / (L / 8), s8 = (i % (L / 8)) * 8; *(LAS u32x4*)(lds + UOFF + bb * USB + s8 * 2) = *(const u32x4*)(hT + ((size_t)c * NB + bb) * L + s8); }
    const int e0 = 8 * fq - fr + L - 16 * (w * NTB + NTB - 1);
    const int abase = (e0 & 7) * FSB + 16 * (e0 >> 3);
    for (int order = 0; order < 2; ++order) {
        const bf16_t* Fr = Fg + ((size_t)order * 256 + c) * (2 * L);
        for (int i = tid; i < 2 * L + 8; i += 512) {
            const bf16_t v = i < 2 * L ? Fr[i] : (bf16_t)0;
#pragma unroll
            for (int r = 0; r < 8; ++r) if (i - r >= 0) *(LAS bf16_t*)(lds + r * FSB + (i - r) * 2) = v;
        }
        if (tid < 64) { const int r = tid >> 3, k = tid & 7; if (k < r) *(LAS bf16_t*)(lds + r * FSB + (2 * L + 8 - 1 - k) * 2) = 0; }
        __syncthreads();
        f32x4 acc[NTB];
#pragma unroll
        for (int a = 0; a < NTB; ++a) acc[a] = (f32x4){0.f, 0.f, 0.f, 0.f};
#pragma unroll 1
        for (int sb = 0; sb < NS; sb += 4) {
            bf16x8 Bf[4];
#pragma unroll
            for (int u = 0; u < 4; ++u) Bf[u] = *(const LAS bf16x8*)(lds + UOFF + fr * USB + (sb + u) * 64 + fq * 16);
            bf16x8 Af[NTB + 6];
#pragma unroll
            for (int k = 0; k < NTB + 6; ++k) Af[k] = *(const LAS bf16x8*)(lds + abase + sb * 64 + k * 32);
#pragma unroll
            for (int a = 0; a < NTB; ++a)
#pragma unroll
                for (int u = 0; u < 4; ++u) acc[a] = MFMA16(Af[NTB - 1 - a + 2 * u], Bf[u], acc[a]);
        }
        __syncthreads();
        const bf16_t* gT = hT + ((size_t)((order + 1) * 256 + c) * NB + fr) * L;
#pragma unroll
        for (int a = 0; a < NTB; ++a) {
            const int t = 16 * (w * NTB + a) + 4 * fq;
            const u32x2 gv = *(const u32x2*)(gT + t);
            LAS u32x2* up = (LAS u32x2*)(lds + UOFF + fr * USB + t * 2);
            const u32x2 uv = *up;
            const float bias = order == 0 ? bias0 : bias1;
            const float r0 = bflo(gv.x) * (acc[a][0] + bflo(uv.x) * bias), r1 = bfhi(gv.x) * (acc[a][1] + bfhi(uv.x) * bias);
            const float r2 = bflo(gv.y) * (acc[a][2] + bflo(uv.y) * bias), r3 = bfhi(gv.y) * (acc[a][3] + bfhi(uv.y) * bias);
            u32x2 pk; pk.x = pk2(r0, r1); pk.y = pk2(r2, r3);
            if (order == 0) *up = pk;
            else *(u32x2*)(hO + ((size_t)c * NB + fr) * L + t) = pk;
        }
        __syncthreads();
    }
}

__device__ __forceinline__ void mixer_phase(const LAS Params* lp, int l, int rp, LAS unsigned char* lds, const XcdBarrier& xb) {
    const bool ctxo = (l == 0);
    const int nq = 64 + 256 + (ctxo ? 256 : 0);
    unsigned* ctr = uni(lp->ctl) + 3584 + 64 * l + 16 * rp;
    LAS int* slot = (LAS int*)(lds + PARAM_OFF + 512);
#ifdef SERIAL_MIX
    for (int r = 0; r < SERIAL_MIX; ++r) { for (int it = blockIdx.x; it < 128; it += gridDim.x) chain_item<0>(lp, l, it, ctxo, lds); xcd_barrier(xb); }
#else
    for (int it = blockIdx.x; it < 128; it += gridDim.x) chain_item<0>(lp, l, it, ctxo, lds);
#endif
#ifndef NOQ
    for (;;) {
        __syncthreads();
        if (threadIdx.x == 0) *slot = (int)atomicAdd(ctr, 1u);
        __syncthreads();
        const int it = *slot;
        if (it >= nq) break;
        if (it < 64) chain_item<1>(lp, l, it, ctxo, lds);
        else if (it < 320) hyena_item<SEQ>(lp, l, it - 64, lds);
        else hyena_item<CTXL>(lp, l, it - 320, lds);
    }
#endif
}

__device__ NOINL void combine_phase(const LAS Params* lp, int l, LAS unsigned char* lds) {
    Params p; LP(gdn_norm_g); LP(hyO); LP(hyOc); LP(hbuf); LP(hyproj); LP(proj);
    LAS bf16_t* ts = (LAS bf16_t*)lds;
    const int tid = otid(), w = tid >> 6, lane = tid & 63;
    const int ntt = (l == 0 ? NTOK : NLAT) / 64;
    float ng8[8];
#pragma unroll
    for (int e = 0; e < 8; ++e) ng8[e] = p.gdn_norm_g[l * 128 + (lane & 15) * 8 + e];
    for (int tt = blockIdx.x; tt < ntt; tt += gridDim.x) {
        const int row0 = tt * 64; const bool il = row0 < NLAT; const int L = il ? SEQ : CTXL;
        const int b = il ? row0 / SEQ : (row0 - NLAT) / CTXL, t0 = il ? row0 % SEQ : (row0 - NLAT) % CTXL;
        const bf16_t* hT = il ? p.hyO : p.hyOc;
        __syncthreads();
        {
            const int ch = tid >> 1, hf = tid & 1;
            const bf16_t* src = hT + ((size_t)ch * NB + b) * L + t0 + hf * 32;
#pragma unroll
            for (int q = 0; q < 4; ++q) {
                const u32x4 v = *(const u32x4*)(src + q * 8);
                const unsigned uu[4] = {v.x, v.y, v.z, v.w};
#pragma unroll
                for (int e = 0; e < 4; ++e) { const int tk = hf * 32 + q * 8 + 2 * e; ts[tk * 264 + ch] = (bf16_t)(uu[e] & 0xFFFFu); ts[(tk + 1) * 264 + ch] = (bf16_t)(uu[e] >> 16); }
            }
        }
        __syncthreads();
        {
            const int tk = tid >> 3, seg = (tid & 7) * 32;
#pragma unroll
            for (int q = 0; q < 4; ++q) *(u32x4*)(p.hbuf + (size_t)(row0 + tk) * DM + seg + q * 8) = *(const LAS u32x4*)(ts + tk * 264 + seg + q * 8);
        }
#pragma unroll
        for (int i = 0; i < 8; ++i) {
            const size_t row = (size_t)(row0 + 8 * w + i);
            float of[8], ob[8], zz[8];
            unpack8(*(const u32x4*)(p.hbuf + row * DM + 256 + lane * 8), of); unpack8(*(const u32x4*)(p.hyproj + row * 768 + lane * 8), ob); unpack8(*(const u32x4*)(p.proj + row * 3072 + 1536 + lane * 8), zz);
            float ss = 0.f;
#pragma unroll
            for (int e = 0; e < 8; ++e) { of[e] += ob[e]; ss += of[e] * of[e]; }
            ss += __shfl_xor(ss, 1); ss += __shfl_xor(ss, 2); ss += __shfl_xor(ss, 4); ss += __shfl_xor(ss, 8);
            const float inv = rsqrtf(ss * (1.f / 128.f) + 1e-6f);
            float o[8];
#pragma unroll
            for (int e = 0; e < 8; ++e) o[e] = of[e] * inv * ng8[e] * siluf(zz[e]);
            u32x4 pk; pk.x = pk2(o[0], o[1]); pk.y = pk2(o[2], o[3]); pk.z = pk2(o[4], o[5]); pk.w = pk2(o[6], o[7]);
            *(u32x4*)(p.hbuf + row * DM + 256 + lane * 8) = pk;
        }
#pragma unroll
        for (int i = 0; i < 4; ++i) {
            const size_t row = (size_t)(row0 + 8 * w + 2 * i + (lane >> 5)); const int l32 = lane & 31;
            float of[8], ob[8], gg[8];
            unpack8(*(const u32x4*)(p.hbuf + row * DM + 768 + l32 * 8), of); unpack8(*(const u32x4*)(p.hyproj + row * 768 + 512 + l32 * 8), ob); unpack8(*(const u32x4*)(p.proj + row * 3072 + 2816 + l32 * 8), gg);
            float s1 = 0.f;
#pragma unroll
            for (int e = 0; e < 8; ++e) { of[e] += ob[e]; s1 += of[e]; }
            s1 += __shfl_xor(s1, 1); s1 += __shfl_xor(s1, 2); s1 += __shfl_xor(s1, 4);
            const float mu = s1 * (1.f / 64.f); float s2 = 0.f;
#pragma unroll
            for (int e = 0; e < 8; ++e) { of[e] -= mu; s2 += of[e] * of[e]; }
            s2 += __shfl_xor(s2, 1); s2 += __shfl_xor(s2, 2); s2 += __shfl_xor(s2, 4);
            const float inv = rsqrtf(s2 * (1.f / 64.f) + 1e-6f);
            float o[8];
#pragma unroll
            for (int e = 0; e < 8; ++e) o[e] = of[e] * inv * siluf(gg[e]);
            u32x4 pk; pk.x = pk2(o[0], o[1]); pk.y = pk2(o[2], o[3]); pk.z = pk2(o[4], o[5]); pk.w = pk2(o[6], o[7]);
            *(u32x4*)(p.hbuf + row * DM + 768 + l32 * 8) = pk;
        }
    }
}

__device__ NOINL void gemm_in_phase(const LAS Params* lp, LAS unsigned char* lds) {
    Params p; LP(hbuf); LP(Wt_in); LP(hyproj); LP(proj); LP(ab); LP(halo);
    pg8::StaticOrder S; S.init(NTOK, 4096, DM, gridDim.x, blockIdx.x); pg8::EpiProj E{p.hyproj, p.proj, p.ab, p.halo};
    pg8::gemm_phase(lds, pg8::Gemm{p.hbuf, p.Wt_in, NTOK, 4096, DM}, S, E);
}
__device__ NOINL void gemm_out_phase(const LAS Params* lp, int l, LAS unsigned char* lds) {
    Params p; LP(hbuf); LP(Wt_out); LP(x); LP(ctx); LP(out); LP(ctx_x); LP(modbuf); LP(hyT); LP(proj);
    const bool tail = (l == 0) && gridDim.x == 256;
    const int Mf = (l == 0 && !tail) ? NTOK : NLAT;
    pg8::StaticOrder S; S.init(Mf, DM, DM, gridDim.x, blockIdx.x, tail ? 1 : 0);
    pg8::EpiRes E{l == 0 ? p.x : p.out, l == 0 ? p.ctx : p.ctx_x, p.out, p.ctx_x, p.modbuf + (size_t)l * 17 * 6144 + 2 * 1024, (float*)p.hyT, p.proj};
    pg8::gemm_phase(lds, pg8::Gemm{p.hbuf, p.Wt_out, Mf, DM, DM}, S, E);
}
__device__ NOINL void gemm_f1_phase(const LAS Params* lp, int l, LAS unsigned char* lds) {
    Params p; LP(hbuf); LP(Wt_f1); LP(proj);
    const int Mf = l == 0 ? NTOK : NLAT;
    pg8::StaticOrder S; S.init(Mf, 2 * FFH, DM, gridDim.x, blockIdx.x); pg8::EpiSwiglu E{p.proj};
    pg8::gemm_phase(lds, pg8::Gemm{p.hbuf, p.Wt_f1, Mf, 2 * FFH, DM}, S, E);
}
__device__ NOINL void gemm_f2_phase(const LAS Params* lp, int l, LAS unsigned char* lds) {
    Params p; LP(proj); LP(Wt_f2); LP(out); LP(ctx_x); LP(modbuf); LP(hyT); LP(hbuf);
    const bool tail = (l == 0) && gridDim.x == 256;
    const int Mf = (l == 0 && !tail) ? NTOK : NLAT;
    pg8::StaticOrder S; S.init(Mf, DM, FFH, gridDim.x, blockIdx.x, tail ? 1 : 0);
    pg8::EpiRes E{p.out, p.ctx_x, p.out, p.ctx_x, p.modbuf + (size_t)l * 17 * 6144 + 5 * 1024, (float*)p.hyT, l == 0 ? p.hbuf : (bf16_t*)nullptr};
    pg8::gemm_phase(lds, pg8::Gemm{p.proj, p.Wt_f2, Mf, DM, FFH}, S, E);
}

__global__ void __launch_bounds__(512) mega_fwd(Params p) {
    extern __shared__ __attribute__((aligned(16))) unsigned char smem_raw[];
    LAS unsigned char* lds = (LAS unsigned char*)smem_raw;
    int ph = 0;
#if MK_MULTI
#define SEAM()
#define RUN (ph >= (int)p.ph_lo && ph < (int)p.ph_hi)
#else
    cg::grid_group grid = cg::this_grid();
    volatile LAS unsigned* xst = (volatile LAS unsigned*)(lds + PARAM_OFF + 520);
    if (threadIdx.x == 0) { xst[0] = 0u; xst[1] = 0u; }
    __syncthreads();
    const XcdBarrier xb = xcd_barrier_post(p.ctl, xst);
#define SEAM() do { if (p.ph_lo == 0x7fffffffLL) grid.sync(); else xcd_barrier(xb); } while (0)
#define RUN true
#endif
    LAS Params* lp = (LAS Params*)(lds + PARAM_OFF);
    if (threadIdx.x == 0) {
#pragma unroll
        for (int i = 0; i < (int)(sizeof(Params) / 8); ++i) ((LAS unsigned long long*)lp)[i] = ((const unsigned long long*)&p)[i];
    }
    __syncthreads();
    for (int rp = 0; rp < ((DUP & 1) ? 2 : 1); ++rp) { if (rp) xcd_barrier(xb); if (RUN && (PHM & 1)) { prep_mod(lp, lds); prep_weights(lp, 0, lds); prep_filters(lp, 0, true, lds); prep_rope(lp); } }
    ++ph; SEAM();
    const bool tailk = gridDim.x == 256;
#pragma unroll 1
    for (int l = 0; l < 2; ++l) {
        const float* xl = l == 0 ? p.x : p.out; const float* xc = l == 0 ? p.ctx : p.ctx_x;
        const float* mod = p.modbuf + (size_t)l * 17 * 6144;
        const int Mf = l == 0 ? NTOK : NLAT;
        if (DUP & 2) { norm_mod_phase(xl, xc, NTOK, p.norm1_g + l * DM, mod, 0, p.hbuf); xcd_barrier(xb); }
        if (RUN && (PHM & 2)) {
            if (l == 1) {
                norm_mod_bf_phase(p.hbuf, NLAT, p.norm1_g + l * DM, mod, 0, p.hbuf);
                if (tailk) norm_mod_phase(xl, xc, NTOK, p.norm1_g + l * DM, mod, 0, p.hbuf, (const float*)p.hyT, p.modbuf + 16 * 6144 + 5 * 1024, nullptr, NLAT);
                else norm_mod_phase(xl, xc, NTOK, p.norm1_g + l * DM, mod, 0, p.hbuf, nullptr, nullptr, nullptr, NLAT);
            } else norm_mod_phase(xl, xc, NTOK, p.norm1_g + l * DM, mod, 0, p.hbuf);
            if (l == 1) { prep_weights(lp, 1, lds); prep_filters(lp, 1, false, lds); }
        }
        ++ph; SEAM();
        for (int rp = 0; rp < ((DUP & 4) ? 2 : 1); ++rp) { if (rp) xcd_barrier(xb); if (RUN && (PHM & 4)) gemm_in_phase(lp, lds); }
        ++ph; SEAM();
        for (int rp = 0; rp < ((DUP & 8) ? 2 : 1); ++rp) { if (rp) xcd_barrier(xb); if (RUN && (PHM & 8)) h1_phase(lp, l, l == 0, lds); }
        if (RUN) qkvn_phase(lp, l, lds);
        ++ph; SEAM();
        for (int rp = 0; rp < ((DUP & 16) ? 2 : 1); ++rp) { if (rp) xcd_barrier(xb); if (RUN && (PHM & 16)) g1_phase(lp, l, lds); }
        ++ph; SEAM();
        for (int rp = 0; rp < ((DUP & 32) ? 2 : 1); ++rp) { if (rp) xcd_barrier(xb); if (RUN && (PHM & 32)) mixer_phase(lp, l, rp, lds, xb); }
        ++ph; SEAM();
        if (RUN && (PHM & 64)) combine_phase(lp, l, lds);
        ++ph; SEAM();
        if (RUN && (PHM & 128)) gemm_out_phase(lp, l, lds);
        ++ph; SEAM();
        if (RUN && (PHM & 256)) {
            norm_mod_bf_phase(p.proj, NLAT, p.norm2_g + l * DM, mod, 3, p.hbuf);
            if (l == 0) {
                if (tailk) norm_mod_phase(p.out, p.ctx, Mf, p.norm2_g + l * DM, mod, 3, p.hbuf, (const float*)p.hyT, mod + 16 * 6144 + 2 * 1024, p.ctx_x, NLAT);
                else norm_mod_phase(p.out, p.ctx_x, Mf, p.norm2_g + l * DM, mod, 3, p.hbuf, nullptr, nullptr, nullptr, NLAT);
            }
        }
        ++ph; SEAM();
        for (int rp = 0; rp < ((DUP & 512) ? 2 : 1); ++rp) { if (rp) xcd_barrier(xb); if (RUN && (PHM & 512)) gemm_f1_phase(lp, l, lds); }
        ++ph; SEAM();
        if (RUN && (PHM & 1024)) gemm_f2_phase(lp, l, lds);
        ++ph; SEAM();
    }
    if (DUP & 64) { for (int i = 0; i < 20; ++i) xcd_barrier(xb); }
    if (RUN && (PHM & 2048)) final_norm_phase(p.out, p.final_norm_g);
}
constexpr int N_PHASES = 1 + 2 * 10 + 1;

extern "C" void kernel_launch(void* const* d_in, const int* in_sizes, int n_in, void* d_out, int out_size, void* d_ws, size_t ws_size, hipStream_t stream) {
    static int grid = 0;
    if (grid == 0) {
        int dev = 0, cus = 0, per_cu = 0;
        hipGetDevice(&dev);
        hipDeviceGetAttribute(&cus, hipDeviceAttributeMultiprocessorCount, dev);
        if (hipFuncSetAttribute((const void*)mega_fwd, hipFuncAttributeMaxDynamicSharedMemorySize, LDS_BYTES) != hipSuccess) { fprintf(stderr, "kernel_launch: hipFuncSetAttribute failed\n"); grid = -1; return; }
        if (hipOccupancyMaxActiveBlocksPerMultiprocessor(&per_cu, (const void*)mega_fwd, 512, LDS_BYTES) != hipSuccess || per_cu < 1) { fprintf(stderr, "kernel_launch: occupancy query gave %d\n", per_cu); per_cu = 1; }
        (void)hipGetLastError();
        grid = cus * per_cu;
    }
    if (grid < 0) return;
    Params p{};
    const float** pin = (const float**)&p.x;
    for (int i = 0; i < 28; ++i) pin[i] = (const float*)d_in[i];
    p.out = (float*)d_out;
    unsigned char* ws = (unsigned char*)d_ws; size_t off = 0;
    auto take = [&](size_t bytes) { unsigned char* r = ws + off; off += (bytes + 255) & ~(size_t)255; return r; };
    p.modbuf = (float*)take((size_t)2 * 17 * 6144 * 4);
    p.Fl = (bf16_t*)take((size_t)2 * 256 * 4096 * 2);
    p.Fc = (bf16_t*)take((size_t)2 * 256 * 512 * 2);
    p.Wt_in = (bf16_t*)take((size_t)4096 * DM * 2);
    p.Wt_out = (bf16_t*)take((size_t)DM * DM * 2);
    p.Wt_f1 = (bf16_t*)take((size_t)2 * FFH * DM * 2);
    p.Wt_f2 = (bf16_t*)take((size_t)DM * FFH * 2);
    p.ctx_x = (float*)take((size_t)NCTX * DM * 4);
    p.hbuf = (bf16_t*)take((size_t)NTOK * DM * 2);
    p.ab = (float*)take((size_t)NTOK * 16 * 4);
    p.hyproj = (bf16_t*)take((size_t)NTOK * 768 * 2);
    p.proj = (bf16_t*)take((size_t)NTOK * 3072 * 2);
    p.hyT = (bf16_t*)take((size_t)768 * NB * SEQ * 2);
    p.hyTc = (bf16_t*)take((size_t)768 * NB * CTXL * 2);
    p.Tbuf = (bf16_t*)take((size_t)4608 * 4096 * 2);
    p.hyO = (bf16_t*)take((size_t)256 * NB * SEQ * 2);
    p.hyOc = (bf16_t*)take((size_t)256 * NB * CTXL * 2);
    p.halo = (bf16_t*)take((size_t)576 * 2 * 1536 * 2);
    p.ropeT = (float*)take((size_t)SEQ * 32 * 2 * 4);
    p.ctl = (unsigned*)take(16384);
    p.gcbuf = (float*)take((size_t)4608 * 192 * 4);
    if (off > ws_size) { fprintf(stderr, "kernel_launch: workspace too small: need %zu, have %zu\n", off, ws_size); return; }
    if (hipMemsetAsync(p.ctl, 0, 16384, stream) != hipSuccess) { fprintf(stderr, "kernel_launch: memset failed\n"); return; }
#if MK_MULTI
    for (int ph = 0; ph < N_PHASES; ++ph) { p.ph_lo = ph; p.ph_hi = ph + 1; hipLaunchKernelGGL(mega_fwd, dim3(grid), dim3(512), LDS_BYTES, stream, p); }
#else
    p.ph_lo = 0; p.ph_hi = N_PHASES;
    void* args[] = {&p};
    hipError_t e = hipLaunchCooperativeKernel((const void*)mega_fwd, dim3(grid), dim3(512), args, LDS_BYTES, stream);
    if (e != hipSuccess) fprintf(stderr, "cooperative launch failed: %s (grid %d)\n", hipGetErrorString(e), grid);
#endif
}
```
